# Optimizing an MI355X kernel written in HIP

```python
import math
import jax, jax.numpy as jnp
from jax import lax
import numpy as np

D_MODEL = 1024
BATCH = 4
SEQ = 8192
DEPTH = 4

N_MIXERS = 2
GDN_HEADS = 8
GDN_HEAD_DIM = 128
GDN_DIM = GDN_HEADS * GDN_HEAD_DIM
GDN_CONV = 4
GDN_CHUNK = 64
S5_DIM = D_MODEL
S5_GROUP = 16
S5_GROUPS = S5_DIM // S5_GROUP
S5_STATE = 64
S5_CHUNK = 128
XA_HEADS = 4
XA_HEAD_DIM = 128
XA_DIM = XA_HEADS * XA_HEAD_DIM
MEM_LEN = 256
D_FF = 4 * D_MODEL
MIX_DIM = GDN_DIM + XA_DIM
GDN_IN = 4 * GDN_DIM + 2 * GDN_HEADS + XA_DIM
S5_IN = S5_DIM + XA_DIM
DN_ALPHA = (2 * DEPTH) ** 0.25
DN_BETA = (8 * DEPTH) ** -0.25
LN_EPS = 1e-5
RMS_EPS = 1e-6
N_GDN_LAYERS = (DEPTH + N_MIXERS - 1) // N_MIXERS
N_S5_LAYERS = DEPTH // N_MIXERS

kernel_name = "hybrid_gdn_s5_memxattn_deepnorm"


def layer_norm(x, g, b):
    xf = x.astype(jnp.float32)
    mu = jnp.mean(xf, axis=-1, keepdims=True)
    var = jnp.mean(jnp.square(xf - mu), axis=-1, keepdims=True)
    return ((xf - mu) * lax.rsqrt(var + LN_EPS) * g.astype(jnp.float32) + b.astype(jnp.float32)).astype(x.dtype)


def l2_normalize(t):
    return t * lax.rsqrt(jnp.sum(jnp.square(t), axis=-1, keepdims=True) + 1e-6)


def causal_depthwise_conv(u, w):
    k_width = w.shape[0]
    length = u.shape[1]
    up = jnp.pad(u, ((0, 0), (k_width - 1, 0), (0, 0)))
    out = up[:, 0:length] * w[0]
    for k in range(1, k_width):
        out = out + up[:, k:k + length] * w[k]
    return out


def gated_delta_rule_chunked(q, k, v, g, beta):
    bsz, length, heads, dk = q.shape
    dv = v.shape[-1]
    c = GDN_CHUNK
    n = length // c

    def to_chunks(t):
        return t.reshape(bsz, n, c, heads, -1).transpose(0, 3, 1, 2, 4)

    q, k, v = to_chunks(q), to_chunks(k), to_chunks(v)
    g = g.reshape(bsz, n, c, heads).transpose(0, 3, 1, 2)
    beta = beta.reshape(bsz, n, c, heads).transpose(0, 3, 1, 2)
    gc = jnp.cumsum(g, axis=-1)

    causal = jnp.tril(jnp.ones((c, c), dtype=bool))
    strict = jnp.tril(jnp.ones((c, c), dtype=bool), k=-1)
    diff = gc[..., :, None] - gc[..., None, :]
    decay = jnp.where(causal, jnp.exp(jnp.where(causal, diff, 0.0)), 0.0)

    kb = k * beta[..., None]
    vb = v * beta[..., None]
    a_strict = jnp.where(strict, jnp.einsum('bhnid,bhnjd->bhnij', kb, k) * decay, 0.0)
    eye = jnp.eye(c, dtype=q.dtype)
    rhs = jnp.concatenate([vb, kb * jnp.exp(gc)[..., None]], axis=-1)
    sol = lax.linalg.triangular_solve(eye + a_strict, rhs, left_side=True, lower=True,
                                      unit_diagonal=True)
    u_blk, w_blk = sol[..., :dv], sol[..., dv:]

    def mv(t):
        return jnp.moveaxis(t, 2, 0)

    def step(state, inp):
        qi, ki, ui, wi, gci, deci = inp
        v_new = ui - jnp.einsum('bhcd,bhde->bhce', wi, state)
        attn = jnp.einsum('bhid,bhjd->bhij', qi, ki) * deci
        o = (jnp.einsum('bhcd,bhde->bhce', qi * jnp.exp(gci)[..., None], state)
             + jnp.einsum('bhij,bhje->bhie', attn, v_new))
        g_last = gci[..., -1]
        k_dec = ki * jnp.exp(g_last[..., None] - gci)[..., None]
        state = state * jnp.exp(g_last)[..., None, None] + jnp.einsum('bhcd,bhce->bhde', k_dec, v_new)
        return state, o

    s0 = jnp.zeros((bsz, heads, dk, dv), dtype=q.dtype)
    _, out = lax.scan(step, s0, (mv(q), mv(k), mv(u_blk), mv(w_blk), mv(gc), mv(decay)))
    return out.transpose(1, 0, 3, 2, 4).reshape(bsz, length, heads, dv)


def gdn_mixer(x, w_in, conv_w, a_log, dt_bias, norm_g):
    bsz, length, _ = x.shape
    f32 = jnp.float32
    proj = x @ w_in
    qkv, z, b_logit, a_logit, xq = jnp.split(
        proj, [3 * GDN_DIM, 4 * GDN_DIM, 4 * GDN_DIM + GDN_HEADS, 4 * GDN_DIM + 2 * GDN_HEADS], axis=-1)
    qkv = jax.nn.silu(causal_depthwise_conv(qkv.astype(f32), conv_w.astype(f32)))
    q, k, v = [t.reshape(bsz, length, GDN_HEADS, GDN_HEAD_DIM) for t in jnp.split(qkv, 3, axis=-1)]
    q = l2_normalize(q) * (GDN_HEAD_DIM ** -0.5)
    k = l2_normalize(k)
    beta = jax.nn.sigmoid(b_logit.astype(f32))
    g = -jnp.exp(a_log.astype(f32)) * jax.nn.softplus(a_logit.astype(f32) + dt_bias.astype(f32))
    o = gated_delta_rule_chunked(q, k, v, g, beta)
    o = o * lax.rsqrt(jnp.mean(jnp.square(o), axis=-1, keepdims=True) + RMS_EPS) * norm_g.astype(f32)
    o = o * jax.nn.silu(z.astype(f32).reshape(bsz, length, GDN_HEADS, GDN_HEAD_DIM))
    return o.reshape(bsz, length, GDN_DIM).astype(x.dtype), xq


def s5_scan(u, abar_re, abar_im, bbar_re, bbar_im, c_re, c_im):
    bsz, length, _ = u.shape
    n = length // S5_CHUNK
    uc = u.reshape(bsz, n, S5_CHUNK, S5_GROUPS, S5_GROUP).transpose(1, 0, 2, 3, 4)
    a_re = jnp.broadcast_to(abar_re, (S5_CHUNK, 1, S5_GROUPS, S5_STATE))
    a_im = jnp.broadcast_to(abar_im, (S5_CHUNK, 1, S5_GROUPS, S5_STATE))

    def combine(e1, e2):
        a1r, a1i, b1r, b1i = e1
        a2r, a2i, b2r, b2i = e2
        return (a2r * a1r - a2i * a1i, a2r * a1i + a2i * a1r,
                a2r * b1r - a2i * b1i + b2r, a2r * b1i + a2i * b1r + b2i)

    def step(h, u_blk):
        h_re, h_im = h
        bu_re = jnp.einsum('bcgi,gpi->cbgp', u_blk, bbar_re)
        bu_im = jnp.einsum('bcgi,gpi->cbgp', u_blk, bbar_im)
        pr, pi, sr, si = lax.associative_scan(combine, (a_re, a_im, bu_re, bu_im), axis=0)
        st_re = sr + pr * h_re - pi * h_im
        st_im = si + pr * h_im + pi * h_re
        y = jnp.einsum('cbgp,gip->bcgi', st_re, c_re) - jnp.einsum('cbgp,gip->bcgi', st_im, c_im)
        return (st_re[-1], st_im[-1]), y

    h0 = jnp.zeros((bsz, S5_GROUPS, S5_STATE), dtype=u.dtype)
    _, ys = lax.scan(step, (h0, h0), uc)
    return ys.transpose(1, 0, 2, 3, 4).reshape(bsz, length, S5_DIM)


def s5_mixer(x, w_in, a_re, a_im, b_re, b_im, c_re, c_im, log_dt, d_skip, w_glu, b_glu):
    f32 = jnp.float32
    proj = x @ w_in
    u, xq = jnp.split(proj, [S5_DIM], axis=-1)
    u = u.astype(f32)
    a_re, a_im = a_re.astype(f32), a_im.astype(f32)
    b_re, b_im = b_re.astype(f32), b_im.astype(f32)
    dt = jnp.exp(log_dt.astype(f32))[:, None]
    mag = jnp.exp(a_re * dt)
    abar_re = mag * jnp.cos(a_im * dt)
    abar_im = mag * jnp.sin(a_im * dt)
    den = jnp.square(a_re) + jnp.square(a_im)
    n_re, n_im = abar_re - 1.0, abar_im
    f_re = (n_re * a_re + n_im * a_im) / den
    f_im = (n_im * a_re - n_re * a_im) / den
    bbar_re = f_re[..., None] * b_re - f_im[..., None] * b_im
    bbar_im = f_re[..., None] * b_im + f_im[..., None] * b_re
    y = s5_scan(u, abar_re, abar_im, bbar_re, bbar_im, c_re.astype(f32), c_im.astype(f32))
    y = y + d_skip.astype(f32) * u
    zg = jax.nn.gelu(y)
    out = zg * jax.nn.sigmoid(zg @ w_glu.astype(f32) + b_glu.astype(f32))
    return out.astype(x.dtype), xq


def memory_attention(xq, mem, w_kv):
    bsz, length, _ = xq.shape
    q = xq.reshape(bsz, length, XA_HEADS, XA_HEAD_DIM)
    k, v = jnp.split(mem @ w_kv, 2, axis=-1)
    k = k.reshape(bsz, -1, XA_HEADS, XA_HEAD_DIM)
    v = v.reshape(bsz, -1, XA_HEADS, XA_HEAD_DIM)
    s = jnp.einsum('blhd,bmhd->bhlm', q, k).astype(jnp.float32) * (XA_HEAD_DIM ** -0.5)
    p = jax.nn.softmax(s, axis=-1).astype(v.dtype)
    o = jnp.einsum('bhlm,bmhd->blhd', p, v)
    return o.reshape(bsz, length, XA_DIM)


def setup_inputs(seed: int = 0) -> dict:
    key = jax.random.key(seed)
    ks = jax.random.split(key, 32)
    nrm = jax.random.normal
    f32 = jnp.float32
    D = D_MODEL
    inp = {}
    inp["x"] = nrm(ks[0], (BATCH, SEQ, D), f32)
    inp["mem"] = nrm(ks[1], (BATCH, MEM_LEN, D), f32)
    inp["w_kv_mem"] = nrm(ks[2], (DEPTH, D, 2 * XA_DIM), f32) * D ** -0.5
    inp["w_o"] = nrm(ks[3], (DEPTH, MIX_DIM, D), f32) * (MIX_DIM ** -0.5) * DN_BETA
    inp["ln1_g"] = 1.0 + 0.02 * nrm(ks[4], (DEPTH, D), f32)
    inp["ln1_b"] = 0.02 * nrm(ks[5], (DEPTH, D), f32)
    inp["ln2_g"] = 1.0 + 0.02 * nrm(ks[6], (DEPTH, D), f32)
    inp["ln2_b"] = 0.02 * nrm(ks[7], (DEPTH, D), f32)
    inp["mlp_w1"] = nrm(ks[8], (DEPTH, D, D_FF), f32) * D ** -0.5
    inp["mlp_w2"] = nrm(ks[9], (DEPTH, D_FF, D), f32) * (D_FF ** -0.5) * DN_BETA
    inp["gdn_w_in"] = nrm(ks[10], (N_GDN_LAYERS, D, GDN_IN), f32) * D ** -0.5
    inp["gdn_conv_w"] = nrm(ks[11], (N_GDN_LAYERS, GDN_CONV, 3 * GDN_DIM), f32) * GDN_CONV ** -0.5
    inp["gdn_a_log"] = jnp.log(jax.random.uniform(ks[12], (N_GDN_LAYERS, GDN_HEADS), f32, 1.0, 16.0))
    dt0 = jnp.exp(jax.random.uniform(ks[13], (N_GDN_LAYERS, GDN_HEADS), f32, math.log(1e-3), math.log(1e-1)))
    inp["gdn_dt_bias"] = dt0 + jnp.log(-jnp.expm1(-dt0))
    inp["gdn_norm_g"] = 1.0 + 0.02 * nrm(ks[14], (N_GDN_LAYERS, GDN_HEAD_DIM), f32)
    inp["s5_w_in"] = nrm(ks[15], (N_S5_LAYERS, D, S5_IN), f32) * D ** -0.5
    sh = (N_S5_LAYERS, S5_GROUPS, S5_STATE)
    inp["s5_a_re"] = -0.5 + 0.01 * nrm(ks[16], sh, f32)
    inp["s5_a_im"] = math.pi * jnp.arange(S5_STATE, dtype=f32) + 0.01 * nrm(ks[17], sh, f32)
    inp["s5_b_re"] = nrm(ks[18], sh + (S5_GROUP,), f32) * (2 * S5_GROUP) ** -0.5
    inp["s5_b_im"] = nrm(ks[19], sh + (S5_GROUP,), f32) * (2 * S5_GROUP) ** -0.5
    shc = (N_S5_LAYERS, S5_GROUPS, S5_GROUP, S5_STATE)
    inp["s5_c_re"] = nrm(ks[20], shc, f32) * (2 * S5_STATE) ** -0.5 * 4.0
    inp["s5_c_im"] = nrm(ks[21], shc, f32) * (2 * S5_STATE) ** -0.5 * 4.0
    inp["s5_log_dt"] = jax.random.uniform(ks[22], (N_S5_LAYERS, S5_GROUPS), f32, math.log(1e-3), math.log(1e-1))
    inp["s5_d"] = nrm(ks[23], (N_S5_LAYERS, S5_DIM), f32)
    inp["s5_w_glu"] = nrm(ks[24], (N_S5_LAYERS, S5_DIM, S5_DIM), f32) * S5_DIM ** -0.5
    inp["s5_b_glu"] = 0.02 * nrm(ks[25], (N_S5_LAYERS, S5_DIM), f32)
    return inp


def reference(x, mem, w_kv_mem, w_o, ln1_g, ln1_b, ln2_g, ln2_b, mlp_w1, mlp_w2,
              gdn_w_in, gdn_conv_w, gdn_a_log, gdn_dt_bias, gdn_norm_g,
              s5_w_in, s5_a_re, s5_a_im, s5_b_re, s5_b_im, s5_c_re, s5_c_im,
              s5_log_dt, s5_d, s5_w_glu, s5_b_glu):
    for i in range(DEPTH):
        j = i // N_MIXERS
        if i % N_MIXERS == 0:
            mix, xq = gdn_mixer(x, gdn_w_in[j], gdn_conv_w[j], gdn_a_log[j], gdn_dt_bias[j], gdn_norm_g[j])
        else:
            mix, xq = s5_mixer(x, s5_w_in[j], s5_a_re[j], s5_a_im[j], s5_b_re[j], s5_b_im[j],
                               s5_c_re[j], s5_c_im[j], s5_log_dt[j], s5_d[j], s5_w_glu[j], s5_b_glu[j])
        cross = memory_attention(xq, mem, w_kv_mem[i])
        h = jnp.concatenate([mix, cross], axis=-1) @ w_o[i]
        x = layer_norm(DN_ALPHA * x + h, ln1_g[i], ln1_b[i])
        f = jnp.square(jax.nn.relu(x @ mlp_w1[i])) @ mlp_w2[i]
        x = layer_norm(DN_ALPHA * x + f, ln2_g[i], ln2_b[i])
    return x
```

```cpp
#include <hip/hip_runtime.h>
#include <hip/hip_cooperative_groups.h>
#include <cstdio>
namespace cg = cooperative_groups;
namespace pg8 {
#define PG8_LAS __attribute__((address_space(3)))
typedef unsigned short bf16_t;
typedef short bf16x8 __attribute__((ext_vector_type(8)));
typedef float f32x4 __attribute__((ext_vector_type(4)));
typedef unsigned u32x4 __attribute__((ext_vector_type(4)));
constexpr int BM = 256, BK = 64, HALF = 128, HTB = HALF * BK * 2  , STAGE_BYTES = 8 * HTB, NXCD = 8, WGM = 8;

__host__ __device__ __forceinline__ int lds_byte(int r, int c) { const int st = (r >> 4) * 2 + (c >> 5), rr = r & 15, cc = c & 31, ob = rr * 64 + cc * 2; return st * 1024 + (ob ^ (((ob >> 9) & 1) << 5)); }
__host__ __device__ __forceinline__ void stage_rc(int b, int& R, int& C) { const int st = b / 1024, sb = b % 1024, swz = sb ^ (((sb >> 9) & 1) << 5); R = (st >> 1) * 16 + swz / 64; C = (st & 1) * 32 + (swz % 64) / 2; }
__host__ __device__ __forceinline__ int perm32(int rho) { const int n = rho >> 4, i = rho & 15; return 8 * (i >> 2) + 4 * n + (i & 3); }

struct Unit { int pm, pn; };
struct Gemm { const bf16_t* A; const bf16_t* Bt; int M, N, K; };

struct StaticOrder {
    int nM, nN, nwg, G, c;
    __host__ __device__ void init(int M, int N, int G_, int c_) { nM = M / BM; nN = N / BM; nwg = nM * nN; G = G_; c = c_; }
    __host__ __device__ bool next(int i, Unit& u) const {
        const long L = (long)i * G + c; if (L >= nwg) return false;
        int wgid = (int)L; { const int q = nwg / NXCD, r = nwg % NXCD, xcd = wgid % NXCD, off = wgid / NXCD; wgid = (xcd < r ? xcd * (q + 1) : r * (q + 1) + (xcd - r) * q) + off; }
        const int nig = WGM * nN, gid = wgid / nig, fm = gid * WGM, gsz = (nM - fm) < WGM ? (nM - fm) : WGM;
        u.pm = fm + ((wgid % nig) % gsz); u.pn = (wgid % nig) / gsz; return true;
    }
    __device__ __forceinline__ void a_ready(const Unit&) const {}
    __device__ __forceinline__ void done(const Unit&) const {}
};
__device__ __forceinline__ unsigned cvt_pk_bf16(float lo, float hi) { unsigned r; asm volatile("v_cvt_pk_bf16_f32 %0, %1, %2" : "=v"(r) : "v"(lo), "v"(hi)); return r; }
typedef float f32x2 __attribute__((ext_vector_type(2)));
template <class Epi, class Sched, bool STAMP = false>
__device__ __forceinline__ void gemm_phase(PG8_LAS unsigned char* lds, const Gemm g, const Sched& S, const Epi& E, unsigned long long* stamps) {
    int tid_ = threadIdx.x; asm volatile("" : "+v"(tid_)); const int tid = tid_, wid = __builtin_amdgcn_readfirstlane(tid >> 6), lane = tid & 63, wr = wid >> 2, wc = wid & 3, fr = lane & 15, fq = lane >> 4;
    const int K = g.K, nt = K / BK;
    int ts_lo = 0, ts_hi = 0, nts = 0; const unsigned long long rt_entry = STAMP ? (unsigned long long)wall_clock64() : 0ull;
#define PG8_STAMP() do { if (STAMP && wid == 0 && nts < 64) { const unsigned long long _c = (unsigned long long)clock64(); \
        ts_lo = (lane == nts) ? (int)(unsigned)_c : ts_lo; ts_hi = (lane == nts) ? (int)(unsigned)(_c >> 32) : ts_hi; ++nts; } } while (0)
    PG8_STAMP();
    unsigned voffA[2], voffB[2];
#pragma unroll
    for (int i = 0; i < 2; ++i) { int R, C; stage_rc(tid * 16 + i * 8192, R, C); const int Rb = Epi::PERM ? ((R & ~31) + perm32(R & 31)) : R;
        voffA[i] = (unsigned)(R * K + C) * 2u; voffB[i] = (unsigned)(Rb * K + C) * 2u; }
    const size_t kstep = (size_t)(BK * 2);
    const size_t hstep = (size_t)HALF * K * 2;
    const size_t tstep = 2 * hstep;
    const unsigned ldsw = (unsigned)wid * 1024u;
    const int aoff = lds_byte(wr * 64 + fr, fq * 8), boff = lds_byte(wc * 32 + fr, fq * 8);
#define PG8_SA(b, h) (((b) * 2 + (h)) * HTB)
#define PG8_SB(b, h) ((4 + (b) * 2 + (h)) * HTB)
#define PG8_STAGE(bufoff, gbase, voff) do { _Pragma("unroll") for (int _i = 0; _i < 2; ++_i) \
        __builtin_amdgcn_global_load_lds((const unsigned*)((const char*)(gbase) + (voff)[_i]), (PG8_LAS unsigned*)(lds + (bufoff) + ldsw + _i * 8192), 16, 0, 0); } while (0)
#define PG8_LDA(dst, b, h) do { _Pragma("unroll") for (int m = 0; m < 4; ++m) _Pragma("unroll") for (int k = 0; k < 2; ++k) dst[m][k] = *(const PG8_LAS bf16x8*)(lds + PG8_SA(b, h) + aoff + m * 2048 + k * 1024); } while (0)
#define PG8_LDB(dst, b, h) do { _Pragma("unroll") for (int n = 0; n < 2; ++n) _Pragma("unroll") for (int k = 0; k < 2; ++k) dst[n][k] = *(const PG8_LAS bf16x8*)(lds + PG8_SB(b, h) + boff + n * 2048 + k * 1024); } while (0)
#define PG8_MMA(ai, bj, At, Bt) do { __builtin_amdgcn_s_setprio(1); _Pragma("unroll") for (int m = 0; m < 4; ++m) _Pragma("unroll") for (int n = 0; n < 2; ++n) _Pragma("unroll") for (int k = 0; k < 2; ++k) \
        acc[ai][bj][m][n] = __builtin_amdgcn_mfma_f32_16x16x32_bf16(Bt[n][k], At[m][k], acc[ai][bj][m][n], 0, 0, 0); __builtin_amdgcn_s_setprio(0); } while (0)
#define PG8_WAIT_V(n) asm volatile("s_waitcnt vmcnt(" #n ")" ::: "memory")
#define PG8_WAIT_L(n) asm volatile("s_waitcnt lgkmcnt(" #n ")" ::: "memory")
#define PG8_BAR __builtin_amdgcn_s_barrier()
#define PG8_SCHED __builtin_amdgcn_sched_barrier(0)
    Unit cur, nxt; int ui = 0;
    if (!S.next(0, cur)) return;
    f32x4 acc[2][2][4][2];
#pragma unroll
    for (int a = 0; a < 2; ++a)
#pragma unroll
        for (int b = 0; b < 2; ++b)
#pragma unroll
            for (int m = 0; m < 4; ++m)
#pragma unroll
                for (int n = 0; n < 2; ++n) acc[a][b][m][n] = (f32x4){0.f, 0.f, 0.f, 0.f};
    bf16x8 At[4][2], B0[2][2], B1[2][2];
    const char* cA = (const char*)g.A + (size_t)cur.pm * tstep; const char* cB = (const char*)g.Bt + (size_t)cur.pn * tstep;
    S.a_ready(cur);
    PG8_STAGE(PG8_SB(0, 0), cB, voffB); PG8_STAGE(PG8_SA(0, 0), cA, voffA); PG8_STAGE(PG8_SB(0, 1), cB + hstep, voffB); PG8_STAGE(PG8_SA(0, 1), cA + hstep, voffA);
    if (wr == 1) PG8_BAR;
    PG8_WAIT_V(4); PG8_BAR;
    PG8_STAGE(PG8_SB(1, 0), cB + kstep, voffB); PG8_STAGE(PG8_SA(1, 0), cA + kstep, voffA); PG8_STAGE(PG8_SB(1, 1), cB + hstep + kstep, voffB);
    PG8_WAIT_V(6); PG8_BAR;
    PG8_STAMP();
    for (;;) {
        const bool has_next = S.next(ui + 1, nxt);
        const char* nA = has_next ? (const char*)g.A + (size_t)nxt.pm * tstep : cA; const char* nB = has_next ? (const char*)g.Bt + (size_t)nxt.pn * tstep : cB;
        for (int t = 0; t < nt; t += 2) {
            const bool last = (t == nt - 2);
            const char* a1 = cA + (size_t)(t + 1) * kstep;
            const char* a2 = last ? nA : cA + (size_t)(t + 2) * kstep; const char* b2 = last ? nB : cB + (size_t)(t + 2) * kstep;
            const char* a3 = a2 + kstep; const char* b3 = b2 + kstep;
            if (last && has_next) S.a_ready(nxt);
            PG8_LDB(B0, 0, 0); PG8_SCHED; PG8_LDA(At, 0, 0); PG8_STAGE(PG8_SA(1, 1), a1 + hstep, voffA);
            PG8_WAIT_L(8); PG8_BAR; PG8_WAIT_L(0); PG8_MMA(0, 0, At, B0); PG8_BAR; PG8_SCHED;
            PG8_LDB(B1, 0, 1); PG8_STAGE(PG8_SB(0, 0), b2, voffB);
            PG8_BAR; PG8_WAIT_L(0); PG8_MMA(0, 1, At, B1); PG8_BAR;
            PG8_LDA(At, 0, 1); PG8_STAGE(PG8_SA(0, 0), a2, voffA);
            PG8_BAR; PG8_WAIT_L(0); PG8_MMA(1, 0, At, B0); PG8_BAR; PG8_SCHED;
            PG8_STAGE(PG8_SB(0, 1), b2 + hstep, voffB);
            PG8_WAIT_V(6); PG8_BAR; PG8_MMA(1, 1, At, B1); PG8_BAR;
            PG8_LDB(B0, 1, 0); PG8_SCHED; PG8_LDA(At, 1, 0); PG8_STAGE(PG8_SA(0, 1), a2 + hstep, voffA);
            PG8_WAIT_L(8); PG8_BAR; PG8_WAIT_L(0); PG8_MMA(0, 0, At, B0); PG8_BAR; PG8_SCHED;
            PG8_LDB(B1, 1, 1); PG8_STAGE(PG8_SB(1, 0), b3, voffB);
            PG8_BAR; PG8_WAIT_L(0); PG8_MMA(0, 1, At, B1); PG8_BAR;
            PG8_LDA(At, 1, 1); PG8_STAGE(PG8_SA(1, 0), a3, voffA);
            PG8_BAR; PG8_WAIT_L(0); PG8_MMA(1, 0, At, B0); PG8_BAR; PG8_SCHED;
            PG8_STAGE(PG8_SB(1, 1), b3 + hstep, voffB);
            PG8_WAIT_V(6); PG8_BAR; PG8_MMA(1, 1, At, B1); PG8_BAR;
        }
        PG8_STAMP();
        if constexpr (!Epi::AFTER_DRAIN) { E(acc, cur, wr, wc, fr, fq); S.done(cur); }
        PG8_STAMP();
        if (!has_next) break;
#pragma unroll
        for (int a = 0; a < 2; ++a)
#pragma unroll
            for (int b = 0; b < 2; ++b)
#pragma unroll
                for (int m = 0; m < 4; ++m)
#pragma unroll
                    for (int n = 0; n < 2; ++n) acc[a][b][m][n] = (f32x4){0.f, 0.f, 0.f, 0.f};
        cur = nxt; cA = nA; cB = nB; ++ui;
    }
    PG8_WAIT_V(0);
    if (wr == 0) PG8_BAR;
    PG8_BAR;
    if constexpr (Epi::AFTER_DRAIN) { E.fused(acc, cur, wr, wc, fr, fq, lds, wid, lane); S.done(cur); }
    PG8_STAMP();
    if (STAMP && wid == 0) { stamps[lane] = lane < nts ? (((unsigned long long)(unsigned)ts_hi << 32) | (unsigned)ts_lo) : 0ull;
        if (lane == 62) stamps[62] = rt_entry; if (lane == 63) stamps[63] = (unsigned long long)wall_clock64(); }
#undef PG8_STAMP
#undef PG8_SA
#undef PG8_SB
#undef PG8_STAGE
#undef PG8_LDA
#undef PG8_LDB
#undef PG8_MMA
#undef PG8_WAIT_V
#undef PG8_WAIT_L
#undef PG8_BAR
#undef PG8_SCHED
}
}
using pg8::bf16_t; using pg8::f32x4; using pg8::u32x4; using pg8::Unit;
#define LAS PG8_LAS
constexpr int T_TOK = 32768, DM = 1024, SEQ = 8192;
constexpr float DN_ALPHA = 1.681792830507429f;
constexpr size_t MiB = 1ull << 20;
constexpr size_t WS_W_IN = 0, WS_W_KV = 10 * MiB, WS_W_O = 12 * MiB, WS_W1 = 15 * MiB, WS_W2 = 23 * MiB, WS_GLU = 31 * MiB, WS_MEMB = 33 * MiB, WS_KV = 35 * MiB, WS_BA = 37 * MiB,
                 WS_XB = 64 * MiB, WS_MIX = 128 * MiB, WS_R1 = 224 * MiB;
constexpr int LDS_BYTES = 131072;
constexpr int NPH = 9;

struct Params { const float* in[26]; float* out; unsigned char* ws; int ph_lo, ph_hi; };

__device__ __forceinline__ float bf2f(bf16_t h) { return __uint_as_float(((unsigned)h) << 16); }
__device__ __forceinline__ float bflo(unsigned w) { return __uint_as_float(w << 16); }
__device__ __forceinline__ float bfhi(unsigned w) { return __uint_as_float(w & 0xffff0000u); }
__device__ __forceinline__ bf16_t f2bf(float x) { return (bf16_t)(pg8::cvt_pk_bf16(x, 0.f) & 0xffffu); }
__device__ __forceinline__ float sigmoidf_(float x) { return 1.f / (1.f + __expf(-x)); }
__device__ __forceinline__ float wave_sum(float v) {
#pragma unroll
    for (int o = 32; o >= 1; o >>= 1) v += __shfl_xor(v, o);
    return v; }
__device__ __forceinline__ float wave_max(float v) {
#pragma unroll
    for (int o = 32; o >= 1; o >>= 1) v = fmaxf(v, __shfl_xor(v, o));
    return v; }
__device__ __forceinline__ void wave_sync() { __builtin_amdgcn_fence(__ATOMIC_RELEASE, "wavefront"); __builtin_amdgcn_wave_barrier(); __builtin_amdgcn_fence(__ATOMIC_ACQUIRE, "wavefront"); }

__device__ __forceinline__ int otid() { int t = threadIdx.x; asm volatile("" : "+v"(t)); return t; }
template <int MODE> struct EpiRoute {
    static constexpr bool PERM = true, AFTER_DRAIN = false;
    bf16_t* o0; bf16_t* o1; bf16_t* o2; float* ba; const bf16_t* zg; const float* bias;
    __device__ __forceinline__ void operator()(const f32x4 (&acc)[2][2][4][2], const Unit& u, int wr, int wc, int fr, int fq) const {
        const int row0 = u.pm * 256 + wr * 64 + fr, colb = u.pn * 256 + wc * 32 + 8 * fq;
#pragma unroll
        for (int ai = 0; ai < 2; ++ai)
#pragma unroll
            for (int m = 0; m < 4; ++m) {
                const size_t row = (size_t)(row0 + ai * 128 + m * 16);
#pragma unroll
                for (int bj = 0; bj < 2; ++bj) {
                    const int col = colb + bj * 128;
                    f32x4 v0 = acc[ai][bj][m][0], v1 = acc[ai][bj][m][1];
                    bf16_t* dst;
                    if (MODE == 0) {
                        if (u.pn < 12) dst = o0 + row * 3072 + col;
                        else if (u.pn < 16) dst = o1 + row * 1024 + (col - 3072);
                        else if (u.pn < 18) dst = o2 + row * 1536 + 1024 + (col - 4096);
                        else { if (col - 4608 < 16) { float* b = ba + row * 16 + (col - 4608); *(f32x4*)b = v0; *(f32x4*)(b + 4) = v1; } continue; }
                    } else if (MODE == 1) {
                        if (u.pn < 4) dst = o0 + row * 1024 + col; else dst = o2 + row * 1536 + col;
                    } else if (MODE == 2) {
#pragma unroll
                        for (int j = 0; j < 4; ++j) { float a = fmaxf(v0[j], 0.f), b = fmaxf(v1[j], 0.f); v0[j] = a * a; v1[j] = b * b; }
                        dst = o0 + row * 4096 + col;
                    } else if (MODE == 3) {
                        dst = o0 + row * 1024 + col;
                    } else {
                        const u32x4 z = *(const u32x4*)(zg + row * 1024 + col);
                        const f32x4 b0 = *(const f32x4*)(bias + col), b1 = *(const f32x4*)(bias + col + 4);
                        v0[0] = bflo(z.x) * sigmoidf_(v0[0] + b0[0]); v0[1] = bfhi(z.x) * sigmoidf_(v0[1] + b0[1]);
                        v0[2] = bflo(z.y) * sigmoidf_(v0[2] + b0[2]); v0[3] = bfhi(z.y) * sigmoidf_(v0[3] + b0[3]);
                        v1[0] = bflo(z.z) * sigmoidf_(v1[0] + b1[0]); v1[1] = bfhi(z.z) * sigmoidf_(v1[1] + b1[1]);
                        v1[2] = bflo(z.w) * sigmoidf_(v1[2] + b1[2]); v1[3] = bfhi(z.w) * sigmoidf_(v1[3] + b1[3]);
                        dst = o2 + row * 1536 + col;
                    }
                    u32x4 w; w.x = pg8::cvt_pk_bf16(v0[0], v0[1]); w.y = pg8::cvt_pk_bf16(v0[2], v0[3]); w.z = pg8::cvt_pk_bf16(v1[0], v1[1]); w.w = pg8::cvt_pk_bf16(v1[2], v1[3]);
                    *(u32x4*)dst = w;
                }
            }
    }
};
struct EpiRes {
    static constexpr bool PERM = false, AFTER_DRAIN = false;
    const float* res; float* out;
    __device__ __forceinline__ void operator()(const f32x4 (&acc)[2][2][4][2], const Unit& u, int wr, int wc, int fr, int fq) const {
        const int row0 = u.pm * 256 + wr * 64 + fr, col0 = u.pn * 256 + wc * 32 + 4 * fq;
#pragma unroll
        for (int ai = 0; ai < 2; ++ai)
#pragma unroll
            for (int m = 0; m < 4; ++m) {
                const size_t off = (size_t)(row0 + ai * 128 + m * 16) * 1024 + col0;
#pragma unroll
                for (int bj = 0; bj < 2; ++bj)
#pragma unroll
                    for (int n = 0; n < 2; ++n) {
                        const f32x4 r = *(const f32x4*)(res + off + bj * 128 + n * 16);
                        *(f32x4*)(out + off + bj * 128 + n * 16) = r * DN_ALPHA + acc[ai][bj][m][n];
                    }
            }
    }
};
template <class Epi> __device__ __forceinline__ void run_gemm(LAS unsigned char* lds, const bf16_t* A, const bf16_t* Bt, int M, int N, int K, const Epi& E) {
    pg8::Gemm g; g.A = A; g.Bt = Bt; g.M = M; g.N = N; g.K = K;
    pg8::StaticOrder S; S.init(M, N, (int)gridDim.x, (int)blockIdx.x);
    pg8::gemm_phase<Epi, pg8::StaticOrder, false>(lds, g, S, E, nullptr);
}

__device__ void transpose_cvt(const float* src, int K, int N, bf16_t* dst, int Npad, int mode, float* tile) {
    const int ntn = Npad / 64, ntk = K / 64;
    for (int t = blockIdx.x; t < ntn * ntk; t += gridDim.x) {
        const int tn = t % ntn, tk = t / ntn, n0 = tn * 64, k0 = tk * 64;
        __syncthreads();
        for (int e = otid(); e < 4096; e += 512) {
            const int kk = e >> 6, nn = e & 63, n = n0 + nn; int sc = n;
            if (mode == 1) sc = n < 4096 ? n : (n < 4608 ? n + 16 : (n < 4624 ? n - 512 : -1));
            else if (n >= N) sc = -1;
            tile[kk * 65 + nn] = sc >= 0 ? src[(size_t)(k0 + kk) * N + sc] : 0.f;
        }
        __syncthreads();
        for (int e = otid(); e < 2048; e += 512) {
            const int nn = e >> 5, kp = e & 31;
            *(unsigned*)(dst + (size_t)(n0 + nn) * K + k0 + 2 * kp) = pg8::cvt_pk_bf16(tile[(2 * kp) * 65 + nn], tile[(2 * kp + 1) * 65 + nn]);
        }
    }
}
__device__ void cvt_rows(const float* src, bf16_t* dst, size_t n) {
    for (size_t i = ((size_t)blockIdx.x * 512 + otid()) * 4; i < n; i += (size_t)gridDim.x * 512 * 4) {
        const f32x4 v = *(const f32x4*)(src + i);
        uint2 w; w.x = pg8::cvt_pk_bf16(v[0], v[1]); w.y = pg8::cvt_pk_bf16(v[2], v[3]); *(uint2*)(dst + i) = w;
    }
}
__device__ void ph_convert(const Params& p, int layer, float* tile) {
    const int j = layer >> 1; unsigned char* ws = p.ws;
    if (layer == 0) { cvt_rows(p.in[0], (bf16_t*)(ws + WS_XB), (size_t)T_TOK * DM); cvt_rows(p.in[1], (bf16_t*)(ws + WS_MEMB), (size_t)1024 * 1024); }
    if ((layer & 1) == 0) transpose_cvt(p.in[10] + (size_t)j * 1024 * 4624, 1024, 4624, (bf16_t*)(ws + WS_W_IN), 4864, 1, tile);
    else { transpose_cvt(p.in[15] + (size_t)j * 1024 * 1536, 1024, 1536, (bf16_t*)(ws + WS_W_IN), 1536, 0, tile);
           transpose_cvt(p.in[24] + (size_t)j * 1024 * 1024, 1024, 1024, (bf16_t*)(ws + WS_GLU), 1024, 0, tile); }
    transpose_cvt(p.in[2] + (size_t)layer * 1024 * 1024, 1024, 1024, (bf16_t*)(ws + WS_W_KV), 1024, 0, tile);
    transpose_cvt(p.in[3] + (size_t)layer * 1536 * 1024, 1536, 1024, (bf16_t*)(ws + WS_W_O), 1024, 0, tile);
    transpose_cvt(p.in[8] + (size_t)layer * 1024 * 4096, 1024, 4096, (bf16_t*)(ws + WS_W1), 4096, 0, tile);
    transpose_cvt(p.in[9] + (size_t)layer * 4096 * 1024, 4096, 1024, (bf16_t*)(ws + WS_W2), 1024, 0, tile);
}

__device__ void ph_ln(float* x, bf16_t* xb, const float* g, const float* b, bool write_bf) {
    const int tid0 = otid(), wave = tid0 >> 6, lane = tid0 & 63;
    for (int row = blockIdx.x * 8 + wave; row < T_TOK; row += gridDim.x * 8) {
        float* xr = x + (size_t)row * 1024; f32x4 v[4]; float s = 0.f;
#pragma unroll
        for (int i = 0; i < 4; ++i) { v[i] = *(const f32x4*)(xr + i * 256 + lane * 4); s += v[i][0] + v[i][1] + v[i][2] + v[i][3]; }
        const float mu = wave_sum(s) * (1.f / 1024.f); float q = 0.f;
#pragma unroll
        for (int i = 0; i < 4; ++i)
#pragma unroll
            for (int k = 0; k < 4; ++k) { const float d = v[i][k] - mu; q += d * d; }
        const float rstd = rsqrtf(wave_sum(q) * (1.f / 1024.f) + 1e-5f);
#pragma unroll
        for (int i = 0; i < 4; ++i) {
            const int c = i * 256 + lane * 4; const f32x4 gg = *(const f32x4*)(g + c), bb = *(const f32x4*)(b + c); f32x4 o;
#pragma unroll
            for (int k = 0; k < 4; ++k) o[k] = (v[i][k] - mu) * rstd * gg[k] + bb[k];
            *(f32x4*)(xr + c) = o;
            if (write_bf) { uint2 w; w.x = pg8::cvt_pk_bf16(o[0], o[1]); w.y = pg8::cvt_pk_bf16(o[2], o[3]); *(uint2*)(xb + (size_t)row * 1024 + c) = w; }
        }
    }
}

__device__ void ph_xattn_naive(bf16_t* mix, const bf16_t* kv, float* ldsf) {
    const int tid0 = otid(), wave = tid0 >> 6, lane = tid0 & 63;
    float* qs = ldsf + wave * 384; float* ps = qs + 128;
    for (int item = blockIdx.x * 8 + wave; item < T_TOK * 4; item += gridDim.x * 8) {
        const int tok = item >> 2, h = item & 3, b = tok >> 13;
        bf16_t* qp = mix + (size_t)tok * 1536 + 1024 + h * 128;
        wave_sync();
        { const unsigned w = *(const unsigned*)(qp + 2 * lane); qs[2 * lane] = bflo(w); qs[2 * lane + 1] = bfhi(w); }
        wave_sync();
        float sc[4];
#pragma unroll
        for (int kk = 0; kk < 4; ++kk) {
            const bf16_t* kr = kv + (size_t)(b * 256 + lane + 64 * kk) * 1024 + h * 128; float a = 0.f;
#pragma unroll
            for (int c = 0; c < 16; ++c) {
                const u32x4 w = *(const u32x4*)(kr + c * 8); const f32x4 q0 = *(const f32x4*)(qs + c * 8), q1 = *(const f32x4*)(qs + c * 8 + 4);
                a += bflo(w.x) * q0[0] + bfhi(w.x) * q0[1] + bflo(w.y) * q0[2] + bfhi(w.y) * q0[3] + bflo(w.z) * q1[0] + bfhi(w.z) * q1[1] + bflo(w.w) * q1[2] + bfhi(w.w) * q1[3];
            }
            sc[kk] = a * 0.08838834764831845f;
        }
        const float mx = wave_max(fmaxf(fmaxf(sc[0], sc[1]), fmaxf(sc[2], sc[3])));
        float e[4], es = 0.f;
#pragma unroll
        for (int kk = 0; kk < 4; ++kk) { e[kk] = __expf(sc[kk] - mx); es += e[kk]; }
        const float inv = 1.f / wave_sum(es);
#pragma unroll
        for (int kk = 0; kk < 4; ++kk) ps[lane + 64 * kk] = e[kk] * inv;
        wave_sync();
        float o0 = 0.f, o1 = 0.f; const bf16_t* vr = kv + (size_t)(b * 256) * 1024 + 512 + h * 128 + 2 * lane;
        for (int k4 = 0; k4 < 64; ++k4) {
            const f32x4 pv = *(const f32x4*)(ps + k4 * 4);
#pragma unroll
            for (int k = 0; k < 4; ++k) { const unsigned w = *(const unsigned*)(vr + (size_t)(k4 * 4 + k) * 1024); o0 += pv[k] * bflo(w); o1 += pv[k] * bfhi(w); }
        }
        *(unsigned*)(qp + 2 * lane) = pg8::cvt_pk_bf16(o0, o1);
    }
}

__device__ void ph_gdn_naive(const Params& p, int j, float* ldsf) {
    if (blockIdx.x >= 32) return;
    const bf16_t* pqkv = (const bf16_t*)(p.ws + WS_R1); const float* ba = (const float*)(p.ws + WS_BA); bf16_t* obuf = (bf16_t*)(p.ws + WS_XB);
    const int b = blockIdx.x >> 3, h = blockIdx.x & 7, tid = otid(), part = tid >> 7, jc = tid & 127, lane = tid & 63;
    float* sq = ldsf; float* sk = sq + 128; float* sv = sk + 128; float* red = sv + 128; float* pr = red + 8; float* po = pr + 512;
    float S[32];
#pragma unroll
    for (int i = 0; i < 32; ++i) S[i] = 0.f;
    const int which = part, c = which * 1024 + h * 128 + jc;
    float cw0 = 0.f, cw1 = 0.f, cw2 = 0.f, cw3 = 0.f, x1 = 0.f, x2 = 0.f, x3 = 0.f;
    if (tid < 384) { const float* cw = p.in[11] + (size_t)j * 4 * 3072; cw0 = cw[c]; cw1 = cw[3072 + c]; cw2 = cw[2 * 3072 + c]; cw3 = cw[3 * 3072 + c]; }
    const float a_coef = -__expf(p.in[12][j * 8 + h]), dtb = p.in[13][j * 8 + h];
    float* mine = which == 0 ? sq : (which == 1 ? sk : sv);
    for (int t = 0; t < SEQ; ++t) {
        const size_t tok = (size_t)b * SEQ + t;
        if (tid < 384) {
            const float x0 = bf2f(pqkv[tok * 3072 + c]); const float cv = cw0 * x3 + cw1 * x2 + cw2 * x1 + cw3 * x0; x3 = x2; x2 = x1; x1 = x0;
            const float s = cv * sigmoidf_(cv); mine[jc] = s;
            if (which < 2) { const float ss = wave_sum(s * s); if (lane == 0) red[tid >> 6] = ss; }
        }
        __syncthreads();
        const float rq = rsqrtf(red[0] + red[1] + 1e-6f) * 0.08838834764831845f, rk = rsqrtf(red[2] + red[3] + 1e-6f);
        const float bl = ba[tok * 16 + h], al = ba[tok * 16 + 8 + h];
        const float beta = sigmoidf_(bl); const float sp_in = al + dtb; const float sp = fmaxf(sp_in, 0.f) + log1pf(__expf(-fabsf(sp_in)));
        const float e = __expf(a_coef * sp);
        float r = 0.f;
#pragma unroll
        for (int dd = 0; dd < 32; ++dd) r += sk[part * 32 + dd] * S[dd];
        pr[part * 128 + jc] = r * rk * e;
        __syncthreads();
        const float rj = pr[jc] + pr[128 + jc] + pr[256 + jc] + pr[384 + jc];
        const float vn = beta * (sv[jc] - rj) * rk; float o = 0.f;
#pragma unroll
        for (int dd = 0; dd < 32; ++dd) { S[dd] = e * S[dd] + sk[part * 32 + dd] * vn; o += sq[part * 32 + dd] * S[dd]; }
        po[part * 128 + jc] = o * rq;
        __syncthreads();
        if (part == 0) obuf[tok * 1024 + h * 128 + jc] = f2bf(po[jc] + po[128 + jc] + po[256 + jc] + po[384 + jc]);
    }
}
__device__ void ph_gdn_gnorm(const Params& p, int j) {
    const bf16_t* obuf = (const bf16_t*)(p.ws + WS_XB); const bf16_t* z = (const bf16_t*)(p.ws + WS_R1 + 192 * MiB); bf16_t* mix = (bf16_t*)(p.ws + WS_MIX);
    const int tid0 = otid(), wave = tid0 >> 6, lane = tid0 & 63; const float g0 = p.in[14][j * 128 + 2 * lane], g1 = p.in[14][j * 128 + 2 * lane + 1];
    for (int item = blockIdx.x * 8 + wave; item < T_TOK * 8; item += gridDim.x * 8) {
        const size_t tok = item >> 3; const int h = item & 7;
        const unsigned ow = *(const unsigned*)(obuf + tok * 1024 + h * 128 + 2 * lane), zw = *(const unsigned*)(z + tok * 1024 + h * 128 + 2 * lane);
        const float o0 = bflo(ow), o1 = bfhi(ow), z0 = bflo(zw), z1 = bfhi(zw);
        const float r = rsqrtf(wave_sum(o0 * o0 + o1 * o1) * (1.f / 128.f) + 1e-6f);
        *(unsigned*)(mix + tok * 1536 + h * 128 + 2 * lane) = pg8::cvt_pk_bf16(o0 * r * g0 * z0 * sigmoidf_(z0), o1 * r * g1 * z1 * sigmoidf_(z1));
    }
}

__device__ __forceinline__ void sincos_d(double x, double& s, double& c) {
    const double k = __builtin_rint(x * 0.15915494309189535); const double r = x - k * 6.283185307179586476925; const double r2 = r * r;
    double ts = 1.0, ss = 1.0, tc = 1.0, cs = 1.0;
#pragma unroll
    for (int n = 1; n <= 13; ++n) { ts *= -r2 / (double)((2 * n) * (2 * n + 1)); ss += ts; tc *= -r2 / (double)((2 * n - 1) * (2 * n)); cs += tc; }
    s = r * ss; c = cs;
}
__device__ __forceinline__ float gelu_tanh(float x) { const float u = 0.7978845608028654f * (x + 0.044715f * x * x * x); const float t = 1.f - 2.f / (__expf(2.f * u) + 1.f); return 0.5f * x * (1.f + t); }
__device__ void ph_s5_naive(const Params& p, int j, float* ldsf) {
    if (blockIdx.x >= 32) return;
    const int tid0 = otid(), wave = tid0 >> 6, lane = tid0 & 63, item = blockIdx.x * 8 + wave, b = item >> 6, g = item & 63;
    const bf16_t* U = (const bf16_t*)(p.ws + WS_R1); bf16_t* ZG = (bf16_t*)(p.ws + WS_R1 + 64 * MiB);
    float* hs = ldsf + wave * 128;
    const size_t gp = ((size_t)j * 64 + g) * 64 + lane;
    const float are = p.in[16][gp], aim = p.in[17][gp], dt = __expf(p.in[22][j * 64 + g]);
    const float mag = expf(are * dt); double sd, cd; sincos_d((double)aim * (double)dt, sd, cd);
    const float abr = mag * (float)cd, abi = mag * (float)sd, den = are * are + aim * aim, nre = abr - 1.f, nim = abi;
    const float fre = (nre * are + nim * aim) / den, fim = (nim * are - nre * aim) / den;
    float bbr[16], bbi[16];
#pragma unroll
    for (int i = 0; i < 16; ++i) { const float br = p.in[18][gp * 16 + i], bi = p.in[19][gp * 16 + i]; bbr[i] = fre * br - fim * bi; bbi[i] = fre * bi + fim * br; }
    const int ci = lane & 15, cp = lane >> 4; float cr[16], cim[16];
#pragma unroll
    for (int pp = 0; pp < 16; ++pp) { const size_t o = (((size_t)j * 64 + g) * 16 + ci) * 64 + cp * 16 + pp; cr[pp] = p.in[20][o]; cim[pp] = p.in[21][o]; }
    const float dsk = p.in[23][j * 1024 + g * 16 + ci];
    float hr = 0.f, hi = 0.f;
    for (int t = 0; t < SEQ; ++t) {
        const size_t tok = (size_t)b * SEQ + t; const bf16_t* up = U + tok * 1024 + g * 16;
        const u32x4 w0 = *(const u32x4*)up, w1 = *(const u32x4*)(up + 8);
        float u[16]; u[0] = bflo(w0.x); u[1] = bfhi(w0.x); u[2] = bflo(w0.y); u[3] = bfhi(w0.y); u[4] = bflo(w0.z); u[5] = bfhi(w0.z); u[6] = bflo(w0.w); u[7] = bfhi(w0.w);
        u[8] = bflo(w1.x); u[9] = bfhi(w1.x); u[10] = bflo(w1.y); u[11] = bfhi(w1.y); u[12] = bflo(w1.z); u[13] = bfhi(w1.z); u[14] = bflo(w1.w); u[15] = bfhi(w1.w);
        float bur = 0.f, bui = 0.f;
#pragma unroll
        for (int i = 0; i < 16; ++i) { bur += bbr[i] * u[i]; bui += bbi[i] * u[i]; }
        const float nr = abr * hr - abi * hi + bur, ni = abr * hi + abi * hr + bui; hr = nr; hi = ni;
        wave_sync();
        hs[lane] = hr; hs[64 + lane] = hi;
        wave_sync();
        float y = 0.f;
#pragma unroll
        for (int q4 = 0; q4 < 4; ++q4) { const f32x4 a = *(const f32x4*)(hs + cp * 16 + q4 * 4), bq = *(const f32x4*)(hs + 64 + cp * 16 + q4 * 4);
#pragma unroll
            for (int k = 0; k < 4; ++k) y += cr[q4 * 4 + k] * a[k] - cim[q4 * 4 + k] * bq[k]; }
        y += __shfl_xor(y, 16); y += __shfl_xor(y, 32);
        const float ui = bf2f(up[ci]);
        y += dsk * ui;
        if (lane < 16) ZG[tok * 1024 + g * 16 + ci] = f2bf(gelu_tanh(y));
    }
}

__global__ void __launch_bounds__(512) fwd_mega(Params p) {
    extern __shared__ __attribute__((aligned(16))) unsigned char shm[];
    LAS unsigned char* lds = (LAS unsigned char*)shm; float* ldsf = (float*)shm;
    cg::grid_group grid = cg::this_grid();
    unsigned char* ws = p.ws;
    bf16_t* XB = (bf16_t*)(ws + WS_XB); bf16_t* MIX = (bf16_t*)(ws + WS_MIX); bf16_t* R1 = (bf16_t*)(ws + WS_R1);
    for (int ph = p.ph_lo; ph < p.ph_hi; ++ph) {
        const int layer = ph / NPH, sub = ph % NPH, j = layer >> 1; const bool gdn = (layer & 1) == 0;
        if (sub == 0) ph_convert(p, layer, ldsf);
        else if (sub == 1) {
            if (gdn) { EpiRoute<0> E; E.o0 = R1; E.o1 = (bf16_t*)(ws + WS_R1 + 192 * MiB); E.o2 = MIX; E.ba = (float*)(ws + WS_BA); E.zg = nullptr; E.bias = nullptr;
                run_gemm(lds, XB, (const bf16_t*)(ws + WS_W_IN), T_TOK, 4864, 1024, E); }
            else { EpiRoute<1> E; E.o0 = R1; E.o1 = nullptr; E.o2 = MIX; E.ba = nullptr; E.zg = nullptr; E.bias = nullptr;
                run_gemm(lds, XB, (const bf16_t*)(ws + WS_W_IN), T_TOK, 1536, 1024, E); }
            { EpiRoute<3> E; E.o0 = (bf16_t*)(ws + WS_KV); E.o1 = nullptr; E.o2 = nullptr; E.ba = nullptr; E.zg = nullptr; E.bias = nullptr;
                run_gemm(lds, (const bf16_t*)(ws + WS_MEMB), (const bf16_t*)(ws + WS_W_KV), 1024, 1024, 1024, E); }
        } else if (sub == 2) {
            if (gdn) ph_gdn_naive(p, j, ldsf); else ph_s5_naive(p, j, ldsf);
            __syncthreads();
            ph_xattn_naive(MIX, (const bf16_t*)(ws + WS_KV), ldsf);
        } else if (sub == 3) {
            if (gdn) ph_gdn_gnorm(p, j);
            else { EpiRoute<4> E; E.o0 = nullptr; E.o1 = nullptr; E.o2 = MIX; E.ba = nullptr; E.zg = (const bf16_t*)(ws + WS_R1 + 64 * MiB); E.bias = p.in[25] + (size_t)j * 1024;
                run_gemm(lds, (const bf16_t*)(ws + WS_R1 + 64 * MiB), (const bf16_t*)(ws + WS_GLU), T_TOK, 1024, 1024, E); }
        } else if (sub == 4) { EpiRes E; E.res = layer == 0 ? p.in[0] : p.out; E.out = p.out; run_gemm(lds, MIX, (const bf16_t*)(ws + WS_W_O), T_TOK, 1024, 1536, E); }
        else if (sub == 5) ph_ln(p.out, XB, p.in[4] + layer * 1024, p.in[5] + layer * 1024, true);
        else if (sub == 6) { EpiRoute<2> E; E.o0 = R1; E.o1 = nullptr; E.o2 = nullptr; E.ba = nullptr; E.zg = nullptr; E.bias = nullptr; run_gemm(lds, XB, (const bf16_t*)(ws + WS_W1), T_TOK, 4096, 1024, E); }
        else if (sub == 7) { EpiRes E; E.res = p.out; E.out = p.out; run_gemm(lds, R1, (const bf16_t*)(ws + WS_W2), T_TOK, 1024, 4096, E); }
        else ph_ln(p.out, XB, p.in[6] + layer * 1024, p.in[7] + layer * 1024, layer < 3);
        if (ph + 1 < p.ph_hi) grid.sync();
    }
}

extern "C" void kernel_launch(void* const* d_in, const int* in_sizes, int n_in, void* d_out, int out_size, void* d_ws, size_t ws_size, hipStream_t stream) {
    static int grid = 0;
    if (grid == 0) {
        int dev = 0, cus = 0, per_cu = 0;
        hipGetDevice(&dev); hipDeviceGetAttribute(&cus, hipDeviceAttributeMultiprocessorCount, dev);
        if (hipFuncSetAttribute((const void*)fwd_mega, hipFuncAttributeMaxDynamicSharedMemorySize, LDS_BYTES) != hipSuccess) fprintf(stderr, "hipFuncSetAttribute failed\n");
        hipOccupancyMaxActiveBlocksPerMultiprocessor(&per_cu, (const void*)fwd_mega, 512, LDS_BYTES);
        if (per_cu < 1) { fprintf(stderr, "occupancy query says %d\n", per_cu); per_cu = 1; }
        (void)hipGetLastError();
        grid = cus;
        if (ws_size < 512 * MiB) fprintf(stderr, "workspace too small: %zu\n", ws_size);
    }
    Params p{};
    for (int i = 0; i < 26; ++i) p.in[i] = (const float*)d_in[i];
    p.out = (float*)d_out; p.ws = (unsigned char*)d_ws; p.ph_lo = 0; p.ph_hi = 4 * NPH;
    void* args[] = {&p};
    hipError_t e = hipLaunchCooperativeKernel((const void*)fwd_mega, dim3(grid), dim3(512), args, LDS_BYTES, stream);
    if (e != hipSuccess) fprintf(stderr, "cooperative launch failed: %s (grid %d)\n", hipGetErrorString(e), grid);
}
```

```cpp
#include <hip/hip_runtime.h>
#include <hip/hip_cooperative_groups.h>
#include <cstdio>
namespace cg = cooperative_groups;
namespace pg8 {
#define PG8_LAS __attribute__((address_space(3)))
typedef unsigned short bf16_t;
typedef short bf16x8 __attribute__((ext_vector_type(8)));
typedef float f32x4 __attribute__((ext_vector_type(4)));
typedef unsigned u32x4 __attribute__((ext_vector_type(4)));
constexpr int BM = 256, BK = 64, HALF = 128, HTB = HALF * BK * 2  , STAGE_BYTES = 8 * HTB, NXCD = 8, WGM = 8;

__host__ __device__ __forceinline__ int lds_byte(int r, int c) { const int st = (r >> 4) * 2 + (c >> 5), rr = r & 15, cc = c & 31, ob = rr * 64 + cc * 2; return st * 1024 + (ob ^ (((ob >> 9) & 1) << 5)); }
__host__ __device__ __forceinline__ void stage_rc(int b, int& R, int& C) { const int st = b / 1024, sb = b % 1024, swz = sb ^ (((sb >> 9) & 1) << 5); R = (st >> 1) * 16 + swz / 64; C = (st & 1) * 32 + (swz % 64) / 2; }
__host__ __device__ __forceinline__ int perm32(int rho) { const int n = rho >> 4, i = rho & 15; return 8 * (i >> 2) + 4 * n + (i & 3); }

struct Unit { int pm, pn, aux; };
struct Gemm { const bf16_t* A; const bf16_t* Bt; int M, N, K; };

struct StaticOrder {
    int nM, nN, nwg, G, c, wv;
    __host__ __device__ void init(int M, int N, int G_, int c_) { nM = M / BM; nN = N / BM; nwg = nM * nN; G = G_; c = c_; }
    __host__ __device__ bool next(int i, Unit& u) const {
        const long L = (long)i * G + c; if (L >= nwg) return false;
        int wgid = (int)L; { const int q = nwg / NXCD, r = nwg % NXCD, xcd = wgid % NXCD, off = wgid / NXCD; wgid = (xcd < r ? xcd * (q + 1) : r * (q + 1) + (xcd - r) * q) + off; }
        const int nig = WGM * nN, gid = wgid / nig, fm = gid * WGM, gsz = (nM - fm) < WGM ? (nM - fm) : WGM;
        u.pm = fm + ((wgid % nig) % gsz); u.pn = (wgid % nig) / gsz; u.aux = i & 1; return true;
    }
    __device__ __forceinline__ void a_ready(const Unit&) const {}
    __device__ __forceinline__ void done(const Unit&) const {}
};
__device__ __forceinline__ unsigned cvt_pk_bf16(float lo, float hi) { unsigned r; asm volatile("v_cvt_pk_bf16_f32 %0, %1, %2" : "=v"(r) : "v"(lo), "v"(hi)); return r; }
typedef float f32x2 __attribute__((ext_vector_type(2)));
template <class Epi, class Sched, bool STAMP = false>
__device__ __forceinline__ void gemm_phase(PG8_LAS unsigned char* lds, const Gemm g, const Sched& S, const Epi& E, unsigned long long* stamps) {
    unsigned m_ = ~0u; asm volatile("" : "+s"(m_)); int tid_ = S.wv * 64 + (int)__builtin_amdgcn_mbcnt_hi(m_, __builtin_amdgcn_mbcnt_lo(m_, 0u)); asm volatile("" : "+v"(tid_)); const int tid = tid_, wid = __builtin_amdgcn_readfirstlane(tid >> 6), lane = tid & 63, wr = wid >> 2, wc = wid & 3, fr = lane & 15, fq = lane >> 4;
    const int K = g.K, nt = K / BK;
    int ts_lo = 0, ts_hi = 0, nts = 0; const unsigned long long rt_entry = STAMP ? (unsigned long long)wall_clock64() : 0ull;
#define PG8_STAMP() do { if (STAMP && wid == 0 && nts < 64) { const unsigned long long _c = (unsigned long long)clock64(); \
        ts_lo = (lane == nts) ? (int)(unsigned)_c : ts_lo; ts_hi = (lane == nts) ? (int)(unsigned)(_c >> 32) : ts_hi; ++nts; } } while (0)
    PG8_STAMP();
    unsigned voffA[2], voffB[2];
#pragma unroll
    for (int i = 0; i < 2; ++i) { int R, C; stage_rc(tid * 16 + i * 8192, R, C); const int Rb = Epi::PERM ? ((R & ~31) + perm32(R & 31)) : R;
        voffA[i] = (unsigned)(R * K + C) * 2u; voffB[i] = (unsigned)(Rb * K + C) * 2u; }
    const size_t kstep = (size_t)(BK * 2);
    const size_t hstep = (size_t)HALF * K * 2;
    const size_t tstep = 2 * hstep;
    const unsigned ldsw = (unsigned)wid * 1024u;
    const int aoff = lds_byte(wr * 64 + fr, fq * 8), boff = lds_byte(wc * 32 + fr, fq * 8);
#define PG8_SA(b, h) (((b) * 2 + (h)) * HTB)
#define PG8_SB(b, h) ((4 + (b) * 2 + (h)) * HTB)
#define PG8_STAGE(bufoff, gbase, voff) do { _Pragma("unroll") for (int _i = 0; _i < 2; ++_i) \
        __builtin_amdgcn_global_load_lds((const unsigned*)((const char*)(gbase) + (voff)[_i]), (PG8_LAS unsigned*)(lds + (bufoff) + ldsw + _i * 8192), 16, 0, 0); } while (0)
#define PG8_LDA(dst, b, h) do { _Pragma("unroll") for (int m = 0; m < 4; ++m) _Pragma("unroll") for (int k = 0; k < 2; ++k) dst[m][k] = *(const PG8_LAS bf16x8*)(lds + PG8_SA(b, h) + aoff + m * 2048 + k * 1024); } while (0)
#define PG8_LDB(dst, b, h) do { _Pragma("unroll") for (int n = 0; n < 2; ++n) _Pragma("unroll") for (int k = 0; k < 2; ++k) dst[n][k] = *(const PG8_LAS bf16x8*)(lds + PG8_SB(b, h) + boff + n * 2048 + k * 1024); } while (0)
#define PG8_MMA(ai, bj, At, Bt) do { __builtin_amdgcn_s_setprio(1); _Pragma("unroll") for (int m = 0; m < 4; ++m) _Pragma("unroll") for (int n = 0; n < 2; ++n) _Pragma("unroll") for (int k = 0; k < 2; ++k) \
        acc[ai][bj][m][n] = __builtin_amdgcn_mfma_f32_16x16x32_bf16(Bt[n][k], At[m][k], acc[ai][bj][m][n], 0, 0, 0); __builtin_amdgcn_s_setprio(0); } while (0)
#define PG8_WAIT_V(n) asm volatile("s_waitcnt vmcnt(" #n ")" ::: "memory")
#define PG8_WAIT_L(n) asm volatile("s_waitcnt lgkmcnt(" #n ")" ::: "memory")
#define PG8_BAR __builtin_amdgcn_s_barrier()
#define PG8_SCHED __builtin_amdgcn_sched_barrier(0)
    Unit cur, nxt; int ui = 0;
    if (!S.next(0, cur)) return;
    f32x4 acc[2][2][4][2];
#pragma unroll
    for (int a = 0; a < 2; ++a)
#pragma unroll
        for (int b = 0; b < 2; ++b)
#pragma unroll
            for (int m = 0; m < 4; ++m)
#pragma unroll
                for (int n = 0; n < 2; ++n) acc[a][b][m][n] = (f32x4){0.f, 0.f, 0.f, 0.f};
    bf16x8 At[4][2], B0[2][2], B1[2][2];
    const char* cA = (const char*)g.A + (size_t)cur.pm * tstep; const char* cB = (const char*)g.Bt + (size_t)cur.pn * tstep;
    S.a_ready(cur);
    PG8_STAGE(PG8_SB(0, 0), cB, voffB); PG8_STAGE(PG8_SA(0, 0), cA, voffA); PG8_STAGE(PG8_SB(0, 1), cB + hstep, voffB); PG8_STAGE(PG8_SA(0, 1), cA + hstep, voffA);
    if (wr == 1) PG8_BAR;
    PG8_WAIT_V(4); PG8_BAR;
    PG8_STAGE(PG8_SB(1, 0), cB + kstep, voffB); PG8_STAGE(PG8_SA(1, 0), cA + kstep, voffA); PG8_STAGE(PG8_SB(1, 1), cB + hstep + kstep, voffB);
    PG8_WAIT_V(6); PG8_BAR;
    PG8_STAMP();
    for (;;) {
        const bool has_next = S.next(ui + 1, nxt);
        const char* nA = has_next ? (const char*)g.A + (size_t)nxt.pm * tstep : cA; const char* nB = has_next ? (const char*)g.Bt + (size_t)nxt.pn * tstep : cB;
        for (int t = 0; t < nt; t += 2) {
            const bool last = (t == nt - 2);
            const char* a1 = cA + (size_t)(t + 1) * kstep;
            const char* a2 = last ? nA : cA + (size_t)(t + 2) * kstep; const char* b2 = last ? nB : cB + (size_t)(t + 2) * kstep;
            const char* a3 = a2 + kstep; const char* b3 = b2 + kstep;
            if (last && has_next) S.a_ready(nxt);
            PG8_LDB(B0, 0, 0); PG8_SCHED; PG8_LDA(At, 0, 0); PG8_STAGE(PG8_SA(1, 1), a1 + hstep, voffA);
            PG8_WAIT_L(8); PG8_BAR; PG8_WAIT_L(0); PG8_MMA(0, 0, At, B0); PG8_BAR; PG8_SCHED;
            PG8_LDB(B1, 0, 1); PG8_STAGE(PG8_SB(0, 0), b2, voffB);
            PG8_BAR; PG8_WAIT_L(0); PG8_MMA(0, 1, At, B1); PG8_BAR;
            PG8_LDA(At, 0, 1); PG8_STAGE(PG8_SA(0, 0), a2, voffA);
            PG8_BAR; PG8_WAIT_L(0); PG8_MMA(1, 0, At, B0); PG8_BAR; PG8_SCHED;
            PG8_STAGE(PG8_SB(0, 1), b2 + hstep, voffB);
            PG8_WAIT_V(6); PG8_BAR; PG8_MMA(1, 1, At, B1); PG8_BAR;
            PG8_LDB(B0, 1, 0); PG8_SCHED; PG8_LDA(At, 1, 0); PG8_STAGE(PG8_SA(0, 1), a2 + hstep, voffA);
            PG8_WAIT_L(8); PG8_BAR; PG8_WAIT_L(0); PG8_MMA(0, 0, At, B0); PG8_BAR; PG8_SCHED;
            PG8_LDB(B1, 1, 1); PG8_STAGE(PG8_SB(1, 0), b3, voffB);
            PG8_BAR; PG8_WAIT_L(0); PG8_MMA(0, 1, At, B1); PG8_BAR;
            PG8_LDA(At, 1, 1); PG8_STAGE(PG8_SA(1, 0), a3, voffA);
            PG8_BAR; PG8_WAIT_L(0); PG8_MMA(1, 0, At, B0); PG8_BAR; PG8_SCHED;
            PG8_STAGE(PG8_SB(1, 1), b3 + hstep, voffB);
            PG8_WAIT_V(6); PG8_BAR; PG8_MMA(1, 1, At, B1); PG8_BAR;
        }
        PG8_STAMP();
        if constexpr (!Epi::AFTER_DRAIN) { E(acc, cur, wr, wc, fr, fq); S.done(cur); }
        PG8_STAMP();
        if (!has_next) break;
#pragma unroll
        for (int a = 0; a < 2; ++a)
#pragma unroll
            for (int b = 0; b < 2; ++b)
#pragma unroll
                for (int m = 0; m < 4; ++m)
#pragma unroll
                    for (int n = 0; n < 2; ++n) acc[a][b][m][n] = (f32x4){0.f, 0.f, 0.f, 0.f};
        cur = nxt; cA = nA; cB = nB; ++ui;
    }
    PG8_WAIT_V(0);
    if (wr == 0) PG8_BAR;
    PG8_BAR;
    if constexpr (Epi::AFTER_DRAIN) { E.fused(acc, cur, wr, wc, fr, fq, lds, wid, lane); S.done(cur); }
    PG8_STAMP();
    if (STAMP && wid == 0) { stamps[lane] = lane < nts ? (((unsigned long long)(unsigned)ts_hi << 32) | (unsigned)ts_lo) : 0ull;
        if (lane == 62) stamps[62] = rt_entry; if (lane == 63) stamps[63] = (unsigned long long)wall_clock64(); }
#undef PG8_STAMP
#undef PG8_SA
#undef PG8_SB
#undef PG8_STAGE
#undef PG8_LDA
#undef PG8_LDB
#undef PG8_MMA
#undef PG8_WAIT_V
#undef PG8_WAIT_L
#undef PG8_BAR
#undef PG8_SCHED
}
}
using pg8::bf16_t; using pg8::f32x4; using pg8::u32x4; using pg8::Unit;
typedef float f32x2_t __attribute__((ext_vector_type(2)));
typedef unsigned u32x2 __attribute__((ext_vector_type(2)));
typedef __bf16 bf16x2_t __attribute__((ext_vector_type(2)));
__device__ __forceinline__ unsigned pk2(float a, float b) { f32x2_t v = {a, b}; bf16x2_t r = __builtin_convertvector(v, bf16x2_t); return __builtin_bit_cast(unsigned, r); }
#define LAS PG8_LAS
constexpr int T_TOK = 32768, DM = 1024, SEQ = 8192;
constexpr float DN_ALPHA = 1.681792830507429f;
constexpr size_t MiB = 1ull << 20;
constexpr size_t WS_W_IN = 0, WS_W_KV = 10 * MiB, WS_W_O = 12 * MiB, WS_W1 = 15 * MiB, WS_W2 = 23 * MiB, WS_GLU = 31 * MiB, WS_MEMB = 33 * MiB, WS_KV = 35 * MiB, WS_BA = 37 * MiB,
                 WS_XB = 64 * MiB, WS_MIX = 128 * MiB, WS_R1 = 224 * MiB;
constexpr size_t WS_HALO = 39 * MiB, WS_CSUM = 49 * MiB, WS_STPA = 52 * MiB, WS_STPB = 56 * MiB, WS_BAR = 60 * MiB;
constexpr int LDS_BYTES = 163840;
constexpr size_t WS_ALT = 480 * MiB;
__device__ __forceinline__ size_t wofs(int layer, size_t even_off, size_t alt_off) { return (layer & 1) ? WS_ALT + alt_off : even_off; }
constexpr int NPH = 11;
constexpr int STAT_LDS = 131072;
constexpr int G2_WAVE_LDS = 17408, SC_BUF = 50176;

struct Params { const float* in[26]; float* out; unsigned char* ws; int ph_lo, ph_hi; };

__device__ __forceinline__ float bf2f(bf16_t h) { return __uint_as_float(((unsigned)h) << 16); }
__device__ __forceinline__ float bflo(unsigned w) { return __uint_as_float(w << 16); }
__device__ __forceinline__ float bfhi(unsigned w) { return __uint_as_float(w & 0xffff0000u); }
__device__ __forceinline__ bf16_t f2bf(float x) { return (bf16_t)(pg8::cvt_pk_bf16(x, 0.f) & 0xffffu); }
__device__ __forceinline__ float sigmoidf_(float x) { return 1.f / (1.f + __expf(-x)); }
__device__ __forceinline__ float wave_sum(float v) {
#pragma unroll
    for (int o = 32; o >= 1; o >>= 1) v += __shfl_xor(v, o);
    return v; }
__device__ __forceinline__ float wave_max(float v) {
#pragma unroll
    for (int o = 32; o >= 1; o >>= 1) v = fmaxf(v, __shfl_xor(v, o));
    return v; }
__device__ __forceinline__ void wave_sync() { __builtin_amdgcn_fence(__ATOMIC_RELEASE, "wavefront"); __builtin_amdgcn_wave_barrier(); __builtin_amdgcn_fence(__ATOMIC_ACQUIRE, "wavefront"); }

__device__ __forceinline__ int otid(int wv) { unsigned m = ~0u; asm volatile("" : "+s"(m)); int t = wv * 64 + (int)__builtin_amdgcn_mbcnt_hi(m, __builtin_amdgcn_mbcnt_lo(m, 0u)); asm volatile("" : "+v"(t)); return t; }
__device__ __forceinline__ void row_stats(const float* stp, size_t row, float& mu, float& rstd) {
    const f32x4* q = (const f32x4*)(stp + row * 32); float s = 0.f, ss = 0.f;
#pragma unroll
    for (int i = 0; i < 8; ++i) { const f32x4 v = q[i]; s += v[0] + v[2]; ss += v[1] + v[3]; }
    mu = s * (1.f / 1024.f); rstd = rsqrtf(fmaxf(ss * (1.f / 1024.f) - mu * mu, 0.f) + 1e-5f);
}
template <int MODE> struct EpiRoute {
    static constexpr bool PERM = true, AFTER_DRAIN = false;
    bf16_t* o0; bf16_t* o1; bf16_t* o2; float* ba; const bf16_t* zg; const float* bias; const float* stp = nullptr; const float* c1 = nullptr; const float* c2 = nullptr; LAS unsigned char* sl = nullptr;
    __device__ __forceinline__ void operator()(const f32x4 (&acc)[2][2][4][2], const Unit& u, int wr, int wc, int fr, int fq) const {
        bf16_t* zdst = (bf16_t*)zg;
        const int row0 = u.pm * 256 + wr * 64 + fr, colb = u.pn * 256 + wc * 32 + 8 * fq;
        f32x4 k1[2][2], k2[2][2];
        if (MODE <= 2 && stp) {
#pragma unroll
            for (int bj = 0; bj < 2; ++bj)
#pragma unroll
                for (int n = 0; n < 2; ++n) { k1[bj][n] = *(const f32x4*)(c1 + colb + bj * 128 + 4 * n); k2[bj][n] = *(const f32x4*)(c2 + colb + bj * 128 + 4 * n); } }
#pragma unroll
        for (int ai = 0; ai < 2; ++ai)
#pragma unroll
            for (int m = 0; m < 4; ++m) {
                const size_t row = (size_t)(row0 + ai * 128 + m * 16);
                float mu = 0.f, rs = 1.f; if (MODE <= 2 && stp) { const f32x2_t st = *(const LAS f32x2_t*)(sl + STAT_LDS + u.aux * 2048 + (int)(row & 255) * 8); mu = st[0]; rs = st[1]; }
#pragma unroll
                for (int bj = 0; bj < 2; ++bj) {
                    const int col = colb + bj * 128;
                    f32x4 v0 = acc[ai][bj][m][0], v1 = acc[ai][bj][m][1];
                    if (MODE <= 2 && stp) { v0 = (v0 - k1[bj][0] * mu) * rs + k2[bj][0]; v1 = (v1 - k1[bj][1] * mu) * rs + k2[bj][1]; }
                    bf16_t* dst;
                    if (MODE == 0) {
                        if (u.pn < 12) { dst = o0 + row * 3072 + col;
                            if (m == 3 && fr >= 13) { u32x4 hw; hw.x = pg8::cvt_pk_bf16(v0[0], v0[1]); hw.y = pg8::cvt_pk_bf16(v0[2], v0[3]); hw.z = pg8::cvt_pk_bf16(v1[0], v1[1]); hw.w = pg8::cvt_pk_bf16(v1[2], v1[3]);
                                *(u32x4*)(o1 + (((row >> 6) * 3 + (size_t)(fr - 13)) * 3072 + col)) = hw; } }
                        else if (u.pn < 16) dst = zdst + row * 1024 + (col - 3072);
                        else if (u.pn < 18) dst = o2 + row * 1536 + 1024 + (col - 4096);
                        else { if (col - 4608 < 16) { float* b = ba + row * 16 + (col - 4608); *(f32x4*)b = v0; *(f32x4*)(b + 4) = v1; } continue; }
                    } else if (MODE == 1) {
                        if (u.pn < 4) dst = o0 + ((size_t)((col >> 4) * 1024) + (row >> 5)) * 640 + (row & 31) * 16 + (col & 15); else dst = o2 + row * 1536 + col;
                    } else if (MODE == 2) {
#pragma unroll
                        for (int j = 0; j < 4; ++j) { float a = fmaxf(v0[j], 0.f), b = fmaxf(v1[j], 0.f); v0[j] = a * a; v1[j] = b * b; }
                        dst = o0 + row * 4096 + col;
                    } else if (MODE == 3) {
                        dst = o0 + row * 1024 + col;
                    } else {
                        const u32x4 z = *(const u32x4*)(zg + row * 1024 + col);
                        const f32x4 b0 = *(const f32x4*)(bias + col), b1 = *(const f32x4*)(bias + col + 4);
                        v0[0] = bflo(z.x) * sigmoidf_(v0[0] + b0[0]); v0[1] = bfhi(z.x) * sigmoidf_(v0[1] + b0[1]);
                        v0[2] = bflo(z.y) * sigmoidf_(v0[2] + b0[2]); v0[3] = bfhi(z.y) * sigmoidf_(v0[3] + b0[3]);
                        v1[0] = bflo(z.z) * sigmoidf_(v1[0] + b1[0]); v1[1] = bfhi(z.z) * sigmoidf_(v1[1] + b1[1]);
                        v1[2] = bflo(z.w) * sigmoidf_(v1[2] + b1[2]); v1[3] = bfhi(z.w) * sigmoidf_(v1[3] + b1[3]);
                        dst = o2 + row * 1536 + col;
                    }
                    u32x4 w; w.x = pg8::cvt_pk_bf16(v0[0], v0[1]); w.y = pg8::cvt_pk_bf16(v0[2], v0[3]); w.z = pg8::cvt_pk_bf16(v1[0], v1[1]); w.w = pg8::cvt_pk_bf16(v1[2], v1[3]);
                    *(u32x4*)dst = w;
                }
            }
    }
};
struct EpiRes {
    static constexpr bool PERM = false, AFTER_DRAIN = false;
    const float* res; const float* g; const float* b; bf16_t* yb; float* stp_out; LAS unsigned char* sl;
    __device__ __forceinline__ void operator()(const f32x4 (&acc)[2][2][4][2], const Unit& u, int wr, int wc, int fr, int fq) const {
        const int row0 = u.pm * 256 + wr * 64 + fr, col0 = u.pn * 256 + wc * 32 + 4 * fq;
        f32x4 gg[2][2], bb[2][2];
        if (!res) {
#pragma unroll
            for (int bj = 0; bj < 2; ++bj)
#pragma unroll
                for (int n = 0; n < 2; ++n) { gg[bj][n] = *(const f32x4*)(g + col0 + bj * 128 + n * 16); bb[bj][n] = *(const f32x4*)(b + col0 + bj * 128 + n * 16); } }
#pragma unroll
        for (int ai = 0; ai < 2; ++ai)
#pragma unroll
            for (int m = 0; m < 4; ++m) {
                const size_t row = (size_t)(row0 + ai * 128 + m * 16), off = row * 1024 + col0;
                float mu = 0.f, rs = 1.f; if (!res) { const f32x2_t st = *(const LAS f32x2_t*)(sl + STAT_LDS + u.aux * 2048 + (int)(row & 255) * 8); mu = st[0]; rs = st[1]; }
                float s = 0.f, ss = 0.f;
#pragma unroll
                for (int bj = 0; bj < 2; ++bj)
#pragma unroll
                    for (int n = 0; n < 2; ++n) {
                        f32x4 r;
                        if (res) r = *(const f32x4*)(res + off + bj * 128 + n * 16);
                        else { const u32x2 yw = *(const u32x2*)(yb + off + bj * 128 + n * 16); const f32x4 yv = {bflo(yw.x), bfhi(yw.x), bflo(yw.y), bfhi(yw.y)}; r = (yv - mu) * rs * gg[bj][n] + bb[bj][n]; }
                        const f32x4 y = r * DN_ALPHA + acc[ai][bj][m][n];
                        u32x2 w; w.x = pk2(y[0], y[1]); w.y = pk2(y[2], y[3]); *(u32x2*)(yb + off + bj * 128 + n * 16) = w;
                        s += y[0] + y[1] + y[2] + y[3]; ss += y[0] * y[0] + y[1] * y[1] + y[2] * y[2] + y[3] * y[3];
                    }
                s += __shfl_xor(s, 16); s += __shfl_xor(s, 32); ss += __shfl_xor(ss, 16); ss += __shfl_xor(ss, 32);
                if (fq == 0) { f32x2_t o; o[0] = s; o[1] = ss; *(f32x2_t*)(stp_out + (row * 16 + u.pn * 4 + wc) * 2) = o; }
            }
    }
};
struct StatOrder : pg8::StaticOrder {
    const float* stp; LAS unsigned char* sl;
    __device__ __forceinline__ void a_ready(const Unit& u) const {
        if (!stp) return;
        const int t = otid(wv), row = t >> 1, hf = t & 1; const f32x4* q = (const f32x4*)(stp + ((size_t)u.pm * 256 + row) * 32 + hf * 16); float s = 0.f, ss = 0.f;
#pragma unroll
        for (int i = 0; i < 4; ++i) { const f32x4 v = q[i]; s += v[0] + v[2]; ss += v[1] + v[3]; }
        s += __shfl_xor(s, 1); ss += __shfl_xor(ss, 1);
        const float mu = s * (1.f / 1024.f), rstd = rsqrtf(fmaxf(ss * (1.f / 1024.f) - mu * mu, 0.f) + 1e-5f);
        if (hf == 0) { f32x2_t o; o[0] = mu; o[1] = rstd; *(LAS f32x2_t*)(sl + STAT_LDS + u.aux * 2048 + row * 8) = o; }
    }
};
template <class Epi> __device__ __forceinline__ void run_gemm_st(int wv, LAS unsigned char* lds, const bf16_t* A, const bf16_t* Bt, int M, int N, int K, const Epi& E, const float* stp) {
    pg8::Gemm g; g.A = A; g.Bt = Bt; g.M = M; g.N = N; g.K = K;
    StatOrder S; S.init(M, N, (int)gridDim.x, (int)blockIdx.x); S.wv = wv; S.stp = stp; S.sl = lds;
    pg8::gemm_phase<Epi, StatOrder, false>(lds, g, S, E, nullptr);
}
template <class Epi> __device__ __forceinline__ void run_gemm(int wv, LAS unsigned char* lds, const bf16_t* A, const bf16_t* Bt, int M, int N, int K, const Epi& E) {
    pg8::Gemm g; g.A = A; g.Bt = Bt; g.M = M; g.N = N; g.K = K;
    pg8::StaticOrder S; S.init(M, N, (int)gridDim.x, (int)blockIdx.x); S.wv = wv;
    pg8::gemm_phase<Epi, pg8::StaticOrder, false>(lds, g, S, E, nullptr);
}

__device__ __forceinline__ void transpose_cvt(int wv, const float* src, int K, int N, bf16_t* dst, int Npad, int mode, float* tile, int blk0 = 0, int nblk = 0) {
    const int ntn = Npad / 64, ntk = K / 64, tid = otid(wv); if (nblk == 0) nblk = (int)gridDim.x; if ((int)blockIdx.x < blk0) return;
    for (int t = (int)blockIdx.x - blk0; t < ntn * ntk; t += nblk) {
        const int tn = t % ntn, tk = t / ntn, n0 = tn * 64, k0 = tk * 64;
        __syncthreads();
#pragma unroll
        for (int i = 0; i < 2; ++i) { const int e = tid + 512 * i, kk = e >> 4, n = n0 + (e & 15) * 4; int sc = n;
            if (mode == 1) sc = n < 4096 ? n : (n < 4608 ? n + 16 : (n < 4624 ? n - 512 : -1));
            else if (n >= N) sc = -1;
            f32x4 v = {0.f, 0.f, 0.f, 0.f}; if (sc >= 0) v = *(const f32x4*)(src + (size_t)(k0 + kk) * N + sc);
            *(f32x4*)(tile + kk * 68 + (e & 15) * 4) = v; }
        __syncthreads();
        { const int nn = tid >> 3, kc = (tid & 7) * 8; float v[8];
#pragma unroll
          for (int e = 0; e < 8; ++e) v[e] = tile[(kc + e) * 68 + nn];
          u32x4 w; w.x = pg8::cvt_pk_bf16(v[0], v[1]); w.y = pg8::cvt_pk_bf16(v[2], v[3]); w.z = pg8::cvt_pk_bf16(v[4], v[5]); w.w = pg8::cvt_pk_bf16(v[6], v[7]);
          *(u32x4*)(dst + (size_t)(n0 + nn) * K + k0 + kc) = w; }
    }
}
__device__ __forceinline__ void transpose_cvt_fold(int wv, const float* src, int N, bf16_t* dst, int Npad, int mode, float* tile, const float* gv, const float* bv, float* c1p, float* c2p, int blk0 = 0, int nblk = 0) {
    const int ntn = Npad / 64, tid = otid(wv); float* tileB = tile + 64 * 68; if (nblk == 0) nblk = (int)gridDim.x; if ((int)blockIdx.x < blk0) return;
    for (int item = (int)blockIdx.x - blk0; item < ntn * 4; item += nblk) {
        const int tn = item % ntn, kq = item / ntn, n0 = tn * 64; float a1 = 0.f, a2 = 0.f;
        for (int tk = kq * 4; tk < kq * 4 + 4; ++tk) { const int k0 = tk * 64;
            __syncthreads();
#pragma unroll
            for (int i = 0; i < 2; ++i) { const int e = tid + 512 * i, kk = e >> 4, n = n0 + (e & 15) * 4; int sc = n;
                if (mode == 1) sc = n < 4096 ? n : (n < 4608 ? n + 16 : (n < 4624 ? n - 512 : -1));
                else if (n >= N) sc = -1;
                f32x4 v = {0.f, 0.f, 0.f, 0.f}; if (sc >= 0) v = *(const f32x4*)(src + (size_t)(k0 + kk) * N + sc);
                *(f32x4*)(tile + kk * 68 + (e & 15) * 4) = v * gv[k0 + kk]; *(f32x4*)(tileB + kk * 68 + (e & 15) * 4) = v * bv[k0 + kk]; }
            __syncthreads();
            { const int nn = tid >> 3, kc = (tid & 7) * 8; float v[8];
#pragma unroll
              for (int e = 0; e < 8; ++e) { v[e] = tile[(kc + e) * 68 + nn]; a2 += tileB[(kc + e) * 68 + nn]; }
              u32x4 w; w.x = pk2(v[0], v[1]); w.y = pk2(v[2], v[3]); w.z = pk2(v[4], v[5]); w.w = pk2(v[6], v[7]);
              a1 += bflo(w.x) + bfhi(w.x) + bflo(w.y) + bfhi(w.y) + bflo(w.z) + bfhi(w.z) + bflo(w.w) + bfhi(w.w);
              *(u32x4*)(dst + (size_t)(n0 + nn) * 1024 + k0 + kc) = w; }
        }
        a1 += __shfl_xor(a1, 1); a1 += __shfl_xor(a1, 2); a1 += __shfl_xor(a1, 4); a2 += __shfl_xor(a2, 1); a2 += __shfl_xor(a2, 2); a2 += __shfl_xor(a2, 4);
        if ((tid & 7) == 0) { c1p[kq * Npad + n0 + (tid >> 3)] = a1; c2p[kq * Npad + n0 + (tid >> 3)] = a2; }
    }
}
__device__ __forceinline__ void cvt_rows(int wv, const float* src, bf16_t* dst, size_t n) {
    const size_t stride = (size_t)gridDim.x * 512 * 4;
    size_t i = ((size_t)blockIdx.x * 512 + otid(wv)) * 4;
    for (; i + 3 * stride < n; i += 4 * stride) { f32x4 v[4];
#pragma unroll
        for (int k = 0; k < 4; ++k) v[k] = *(const f32x4*)(src + i + k * stride);
#pragma unroll
        for (int k = 0; k < 4; ++k) { uint2 w; w.x = pg8::cvt_pk_bf16(v[k][0], v[k][1]); w.y = pg8::cvt_pk_bf16(v[k][2], v[k][3]); *(uint2*)(dst + i + k * stride) = w; } }
    for (; i < n; i += stride) { const f32x4 v = *(const f32x4*)(src + i); uint2 w; w.x = pg8::cvt_pk_bf16(v[0], v[1]); w.y = pg8::cvt_pk_bf16(v[2], v[3]); *(uint2*)(dst + i) = w; }
}
__device__ __forceinline__ void csum_finalize(int wv, const float* c1p, const float* c2p, float* c1, float* c2, int NP) {
    for (int n = blockIdx.x * 512 + otid(wv); n < NP; n += gridDim.x * 512) { c1[n] = c1p[n] + c1p[NP + n] + c1p[2 * NP + n] + c1p[3 * NP + n]; c2[n] = c2p[n] + c2p[NP + n] + c2p[2 * NP + n] + c2p[3 * NP + n]; }
}
__device__ __forceinline__ void ph_convert_in(int wv, const Params& p, int layer, float* tile, int blk0 = 0, int nblk = 0) {
    const int j = layer >> 1; unsigned char* ws = p.ws; float* cs = (float*)(ws + WS_CSUM);
    const float* g2 = p.in[6] + (layer > 0 ? layer - 1 : 0) * 1024; const float* b2 = p.in[7] + (layer > 0 ? layer - 1 : 0) * 1024;
    if ((layer & 1) == 0) { if (layer == 0) transpose_cvt(wv, p.in[10] + (size_t)j * 1024 * 4624, 1024, 4624, (bf16_t*)(ws + WS_W_IN), 4864, 1, tile, blk0, nblk);
                            else transpose_cvt_fold(wv, p.in[10] + (size_t)j * 1024 * 4624, 4624, (bf16_t*)(ws + WS_W_IN), 4864, 1, tile, g2, b2, cs, cs + 19456, blk0, nblk); }
    else { transpose_cvt_fold(wv, p.in[15] + (size_t)j * 1024 * 1536, 1536, (bf16_t*)(ws + WS_W_IN), 1536, 0, tile, g2, b2, cs, cs + 19456, blk0, nblk);
           transpose_cvt(wv, p.in[24] + (size_t)j * 1024 * 1024, 1024, 1024, (bf16_t*)(ws + WS_GLU), 1024, 0, tile, blk0, nblk); }
    transpose_cvt(wv, p.in[2] + (size_t)layer * 1024 * 1024, 1024, 1024, (bf16_t*)(ws + WS_W_KV), 1024, 0, tile, blk0, nblk);
}
__device__ __forceinline__ void ph_convert_wo(int wv, const Params& p, int layer, float* tile, int blk0 = 0, int nblk = 0) { transpose_cvt(wv, p.in[3] + (size_t)layer * 1536 * 1024, 1536, 1024, (bf16_t*)(p.ws + wofs(layer, WS_W_O, 0)), 1024, 0, tile, blk0, nblk); }
__device__ __forceinline__ void ph_convert_w1(int wv, const Params& p, int layer, float* tile, int blk0 = 0, int nblk = 0) { float* cs = (float*)(p.ws + WS_CSUM);
    transpose_cvt_fold(wv, p.in[8] + (size_t)layer * 1024 * 4096, 4096, (bf16_t*)(p.ws + wofs(layer, WS_W1, 3 * MiB)), 4096, 0, tile, p.in[4] + layer * 1024, p.in[5] + layer * 1024, cs + ((layer & 1) ? 89600 : 38912), cs + ((layer & 1) ? 105984 : 55296), blk0, nblk); }
__device__ __forceinline__ void ph_convert_w2(int wv, const Params& p, int layer, float* tile, int blk0 = 0, int nblk = 0) { transpose_cvt(wv, p.in[9] + (size_t)layer * 4096 * 1024, 4096, 1024, (bf16_t*)(p.ws + wofs(layer, WS_W2, 11 * MiB)), 1024, 0, tile, blk0, nblk); }

__device__ __forceinline__ void ph_ln_final(int wv, const bf16_t* yb, float* out, const float* g, const float* b) {
    const int tid0 = otid(wv), wave = tid0 >> 6, lane = tid0 & 63;
    for (int row = blockIdx.x * 8 + wave; row < T_TOK; row += gridDim.x * 8) {
        const bf16_t* yr = yb + (size_t)row * 1024; f32x4 v[4]; float s = 0.f;
#pragma unroll
        for (int i = 0; i < 4; ++i) { const u32x2 w = *(const u32x2*)(yr + i * 256 + lane * 4); v[i] = (f32x4){bflo(w.x), bfhi(w.x), bflo(w.y), bfhi(w.y)}; s += v[i][0] + v[i][1] + v[i][2] + v[i][3]; }
        const float mu = wave_sum(s) * (1.f / 1024.f); float q = 0.f;
#pragma unroll
        for (int i = 0; i < 4; ++i)
#pragma unroll
            for (int k = 0; k < 4; ++k) { const float d = v[i][k] - mu; q += d * d; }
        const float rstd = rsqrtf(wave_sum(q) * (1.f / 1024.f) + 1e-5f);
#pragma unroll
        for (int i = 0; i < 4; ++i) {
            const int c = i * 256 + lane * 4; const f32x4 gg = *(const f32x4*)(g + c), bb = *(const f32x4*)(b + c); f32x4 o;
#pragma unroll
            for (int k = 0; k < 4; ++k) o[k] = (v[i][k] - mu) * rstd * gg[k] + bb[k];
            *(f32x4*)(out + (size_t)row * 1024 + c) = o;
        }
    }
}

__device__ __forceinline__ void ph_gdn_gnorm(int wv, const Params& p, int j, bf16_t* dummy = nullptr) {
    const bf16_t* z = (const bf16_t*)(p.ws + WS_R1 + 192 * MiB); bf16_t* mix = (bf16_t*)(p.ws + WS_MIX); (void)dummy;
    const int tid0 = otid(wv), wave = tid0 >> 6, lane = tid0 & 63, sub = lane >> 4, l16 = lane & 15;
    const f32x4 g0 = *(const f32x4*)(p.in[14] + j * 128 + l16 * 8), g1 = *(const f32x4*)(p.in[14] + j * 128 + l16 * 8 + 4);
    for (int i4 = blockIdx.x * 8 + wave; i4 < T_TOK * 2; i4 += gridDim.x * 16) {
        bf16_t* op[2]; u32x4 ow[2], zw[2];
#pragma unroll
        for (int k = 0; k < 2; ++k) { if (i4 + k * (int)gridDim.x * 8 >= T_TOK * 2) { op[k] = nullptr; continue; } const int item = (i4 + k * (int)gridDim.x * 8) * 4 + sub; const size_t tok = (size_t)(item >> 3); const int h = item & 7;
            op[k] = mix + tok * 1536 + h * 128 + l16 * 8; ow[k] = *(const u32x4*)op[k]; zw[k] = *(const u32x4*)(z + tok * 1024 + h * 128 + l16 * 8); }
#pragma unroll
        for (int k = 0; k < 2; ++k) { if (!op[k]) continue;
            const float o[8] = {bflo(ow[k].x), bfhi(ow[k].x), bflo(ow[k].y), bfhi(ow[k].y), bflo(ow[k].z), bfhi(ow[k].z), bflo(ow[k].w), bfhi(ow[k].w)}, zz[8] = {bflo(zw[k].x), bfhi(zw[k].x), bflo(zw[k].y), bfhi(zw[k].y), bflo(zw[k].z), bfhi(zw[k].z), bflo(zw[k].w), bfhi(zw[k].w)};
            float ss = 0.f;
#pragma unroll
            for (int e = 0; e < 8; ++e) ss += o[e] * o[e];
            ss += __shfl_xor(ss, 1); ss += __shfl_xor(ss, 2); ss += __shfl_xor(ss, 4); ss += __shfl_xor(ss, 8);
            const float r = rsqrtf(ss * (1.f / 128.f) + 1e-6f);
            float y[8];
#pragma unroll
            for (int e = 0; e < 8; ++e) y[e] = o[e] * r * (e < 4 ? g0[e & 3] : g1[e & 3]) * zz[e] * sigmoidf_(zz[e]);
            u32x4 w; w.x = pk2(y[0], y[1]); w.y = pk2(y[2], y[3]); w.z = pk2(y[4], y[5]); w.w = pk2(y[6], y[7]);
            *(u32x4*)op[k] = w; }
    }
}

typedef short bf16x8 __attribute__((ext_vector_type(8)));
typedef short s16x4 __attribute__((ext_vector_type(4)));
__device__ __forceinline__ bf16x8 pack8(const f32x4& lo, const f32x4& hi) { u32x4 w; w.x = pk2(lo[0], lo[1]); w.y = pk2(lo[2], lo[3]); w.z = pk2(hi[0], hi[1]); w.w = pk2(hi[2], hi[3]); return __builtin_bit_cast(bf16x8, w); }
#define MFMA16(a, b, c) __builtin_amdgcn_mfma_f32_16x16x32_bf16((a), (b), (c), 0, 0, 0)

template <int K> __device__ __forceinline__ float dpp_shr(float x) { return __int_as_float(__builtin_amdgcn_update_dpp(0, __float_as_int(x), 0x110 + K, 0xf, 0xf, true)); }
template <int K> __device__ __forceinline__ float dpp_shl(float x) { return __int_as_float(__builtin_amdgcn_update_dpp(0, __float_as_int(x), 0x100 + K, 0xf, 0xf, true)); }
__device__ __forceinline__ void unpack8(const u32x4& w, float (&f)[8]) { f[0] = bflo(w.x); f[1] = bfhi(w.x); f[2] = bflo(w.y); f[3] = bfhi(w.y); f[4] = bflo(w.z); f[5] = bfhi(w.z); f[6] = bflo(w.w); f[7] = bfhi(w.w); }

__device__ __forceinline__ void ph_gdn_prep(int wv, const Params& p, int j, unsigned char* smem, const bool dry = false) {
    for (int pair = blockIdx.x; pair < 512; pair += gridDim.x) {
        const int tid = otid(wv), wave = tid >> 6, lane = tid & 63, r = lane & 15, g = lane >> 4, h = wave;
        bf16_t* pq = (bf16_t*)(p.ws + WS_R1); float* BA = (float*)(p.ws + WS_BA); const bf16_t* HALO = (const bf16_t*)(p.ws + WS_HALO);
        LAS unsigned char* lds = (LAS unsigned char*)smem;
        float* Al = (float*)(smem + wave * G2_WAVE_LDS); float* sgc = Al + 4096; float* sbeta = sgc + 64;
        int jo = j; asm volatile("" : "+s"(jo));
        const float a_coef = -__expf(p.in[12][jo * 8 + h]), dtb = p.in[13][jo * 8 + h];
        const float* cwb = p.in[11] + (size_t)jo * 4 * 3072;
        const int n = pair & 127; const size_t t0 = (size_t)pair * 64;
        const bf16_t* halo = n > 0 ? HALO + (size_t)(pair - 1) * 3 * 3072 : nullptr;
        unsigned char* blob = (unsigned char*)p.out + ((size_t)pair * 8 + h) * 16384;
        {
            const size_t tok = t0 + lane; const float bl = BA[tok * 16 + h], al = BA[tok * 16 + 8 + h];
            const float beta = sigmoidf_(bl); const float spi = al + dtb; const float sp = fmaxf(spi, 0.f) + log1pf(__expf(-fabsf(spi)));
            float gc = a_coef * sp;
            { int l2 = lane; asm volatile("" : "+v"(l2));
#pragma unroll
              for (int o = 1; o < 64; o <<= 1) { const float t = __int_as_float(__builtin_amdgcn_ds_bpermute((l2 - o) << 2, __float_as_int(gc))); if (l2 >= o) gc += t; } }
            wave_sync();
            sgc[lane] = gc; sbeta[lane] = beta; BA[tok * 16 + h] = beta; BA[tok * 16 + 8 + h] = gc;
            wave_sync();
        }
        { LAS float* wl = (LAS float*)(lds + wave * G2_WAVE_LDS);
#pragma unroll
          for (int e = 0; e < 24; ++e) { const int idx = e * 64 + lane, st = idx >> 7, c = idx & 127; wl[idx] = cwb[(st & 3) * 3072 + (st >> 2) * 1024 + h * 128 + c]; }
          wave_sync();
#pragma unroll 1
          for (int si = 0; si < 3; ++si) { const int sec = si == 0 ? 2 : si - 1; const int colbase = sec * 1024 + h * 128;
            int lane_ = lane; asm volatile("" : "+v"(lane_)); const int r = lane_ & 15, g = lane_ >> 4;
            u32x4 cur[4], prv[4], nxt[4];
#pragma unroll
            for (int ks = 0; ks < 4; ++ks) { cur[ks] = *(const u32x4*)(pq + (t0 + 48 + r) * 3072 + colbase + 32 * ks + 8 * g); prv[ks] = *(const u32x4*)(pq + (t0 + 32 + r) * 3072 + colbase + 32 * ks + 8 * g); nxt[ks] = (u32x4){0u, 0u, 0u, 0u}; }
#pragma unroll 1
            for (int mi = 0; mi < 4; ++mi) { const int mb = 3 - mi; float cv[4][8];
                if (mb >= 2) {
#pragma unroll
                    for (int ks = 0; ks < 4; ++ks) nxt[ks] = *(const u32x4*)(pq + (t0 + 16 * (mb - 2) + r) * 3072 + colbase + 32 * ks + 8 * g); }
                else if (mb == 1) { const bf16_t* hp = halo ? halo + (size_t)(r >= 13 ? r - 13 : 0) * 3072 : pq + t0 * 3072;
#pragma unroll
                    for (int ks = 0; ks < 4; ++ks) { u32x4 w = *(const u32x4*)(hp + colbase + 32 * ks + 8 * g); if (!halo) w = (u32x4){0u, 0u, 0u, 0u}; nxt[ks] = w; } }
#pragma unroll
                for (int ks = 0; ks < 4; ++ks) { float xf[8], pf[8], acc[8]; unpack8(cur[ks], xf); unpack8(prv[ks], pf);
                    const LAS float* wk = wl + sec * 512 + 32 * ks + 8 * g;
                    { const f32x4 w0 = *(const LAS f32x4*)(wk + 384), w1 = *(const LAS f32x4*)(wk + 388);
#pragma unroll
                      for (int e = 0; e < 8; ++e) acc[e] = (e < 4 ? w0[e & 3] : w1[e & 3]) * xf[e]; }
                    { const f32x4 w0 = *(const LAS f32x4*)(wk + 256), w1 = *(const LAS f32x4*)(wk + 260);
#pragma unroll
                      for (int e = 0; e < 8; ++e) acc[e] += (e < 4 ? w0[e & 3] : w1[e & 3]) * (dpp_shr<1>(xf[e]) + dpp_shl<15>(pf[e])); }
                    { const f32x4 w0 = *(const LAS f32x4*)(wk + 128), w1 = *(const LAS f32x4*)(wk + 132);
#pragma unroll
                      for (int e = 0; e < 8; ++e) acc[e] += (e < 4 ? w0[e & 3] : w1[e & 3]) * (dpp_shr<2>(xf[e]) + dpp_shl<14>(pf[e])); }
                    { const f32x4 w0 = *(const LAS f32x4*)(wk), w1 = *(const LAS f32x4*)(wk + 4);
#pragma unroll
                      for (int e = 0; e < 8; ++e) acc[e] += (e < 4 ? w0[e & 3] : w1[e & 3]) * (dpp_shr<3>(xf[e]) + dpp_shl<13>(pf[e])); }
#pragma unroll
                    for (int e = 0; e < 8; ++e) cv[ks][e] = acc[e] * sigmoidf_(acc[e]); }
                float rn = 1.f;
                if (sec < 2) { float ss = 0.f;
#pragma unroll
                    for (int ks = 0; ks < 4; ++ks)
#pragma unroll
                        for (int e = 0; e < 8; ++e) ss += cv[ks][e] * cv[ks][e];
                    ss += __shfl_xor(ss, 16); ss += __shfl_xor(ss, 32);
                    rn = rsqrtf(ss + 1e-6f) * (sec == 0 ? 0.08838834764831845f : 1.f); }
#pragma unroll
                for (int ks = 0; ks < 4; ++ks) { u32x4 w; w.x = pk2(cv[ks][0] * rn, cv[ks][1] * rn); w.y = pk2(cv[ks][2] * rn, cv[ks][3] * rn); w.z = pk2(cv[ks][4] * rn, cv[ks][5] * rn); w.w = pk2(cv[ks][6] * rn, cv[ks][7] * rn);
                    *(u32x4*)(pq + (t0 + 16 * mb + r) * 3072 + colbase + 32 * ks + 8 * g) = w; }
#pragma unroll
                for (int ks = 0; ks < 4; ++ks) { cur[ks] = prv[ks]; prv[ks] = nxt[ks]; }
            }
          }
        }
        wave_sync();
        bf16x8 kf[4][4];
#pragma unroll
        for (int mb = 0; mb < 4; ++mb)
#pragma unroll
            for (int ks = 0; ks < 4; ++ks) kf[mb][ks] = *(const bf16x8*)(pq + (t0 + 16 * mb + r) * 3072 + 1024 + h * 128 + 32 * ks + 8 * g);
        f32x4 gcr[4], br[4]; float gcc[4];
#pragma unroll
        for (int mb = 0; mb < 4; ++mb) { gcr[mb] = *(const f32x4*)(sgc + 16 * mb + 4 * g); br[mb] = *(const f32x4*)(sbeta + 16 * mb + 4 * g); gcc[mb] = sgc[16 * mb + r]; }
#pragma unroll
        for (int mb = 0; mb < 4; ++mb)
#pragma unroll
            for (int nb = 0; nb <= mb; ++nb) {
                f32x4 acc = {0.f, 0.f, 0.f, 0.f};
#pragma unroll
                for (int ks = 0; ks < 4; ++ks) acc = MFMA16(kf[mb][ks], kf[nb][ks], acc);
#pragma unroll
                for (int jj = 0; jj < 4; ++jj) { const int i = 16 * mb + 4 * g + jj, jc = 16 * nb + r;
                    Al[i * 64 + jc] = (jc < i) ? br[mb][jj] * acc[jj] * __expf(gcr[mb][jj] - gcc[nb]) : 0.f; }
            }
#pragma unroll
        for (int ib = 0; ib < 4; ++ib) {
            bf16x8 qfi[4];
#pragma unroll
            for (int ks = 0; ks < 4; ++ks) qfi[ks] = *(const bf16x8*)(pq + (t0 + 16 * ib + r) * 3072 + h * 128 + 32 * ks + 8 * g);
#pragma unroll
            for (int ks2 = 0; ks2 < 2; ++ks2) {
                f32x4 t2[2];
#pragma unroll
                for (int hh = 0; hh < 2; ++hh) { const int jb = 2 * ks2 + hh; f32x4 acc = {0.f, 0.f, 0.f, 0.f};
                    if (jb <= ib) {
#pragma unroll
                        for (int ks = 0; ks < 4; ++ks) acc = MFMA16(kf[jb][ks], qfi[ks], acc);
#pragma unroll
                        for (int jj = 0; jj < 4; ++jj) { const int jt = 16 * jb + 4 * g + jj, it = 16 * ib + r;
                            acc[jj] = (jt <= it) ? acc[jj] * __expf(gcc[ib] - gcr[jb][jj]) : 0.f; }
                    }
                    t2[hh] = acc; }
                *(bf16x8*)(blob + 8192 + ((ib * 2 + ks2) * 64 + lane) * 16) = pack8(t2[0], t2[1]);
            }
        }
        wave_sync();
        float Tr[64];
#pragma unroll
        for (int i = 0; i < 64; ++i) {
            float acc = 0.f;
#pragma unroll
            for (int k4 = 0; k4 < (i + 3) / 4; ++k4) { const f32x4 a = *(const f32x4*)(Al + i * 64 + k4 * 4);
#pragma unroll
                for (int e = 0; e < 4; ++e) if (k4 * 4 + e < i) acc += a[e] * Tr[k4 * 4 + e]; }
            Tr[i] = (lane == i) ? 1.f : -acc;
        }
        wave_sync();
        bf16_t* Tb = (bf16_t*)Al;
#pragma unroll
        for (int i = 0; i < 64; ++i) Tb[i * 64 + lane] = (bf16_t)(pk2(Tr[i], 0.f) & 0xffffu);
        wave_sync();
#pragma unroll
        for (int mb = 0; mb < 4; ++mb)
#pragma unroll
            for (int ks2 = 0; ks2 < 2; ++ks2) { const bf16_t* rowp = Tb + (16 * mb + r) * 64 + 32 * ks2 + 4 * g;
                const uint2 lo = *(const uint2*)rowp, hi = *(const uint2*)(rowp + 16); u32x4 w; w.x = lo.x; w.y = lo.y; w.z = hi.x; w.w = hi.y;
                *(u32x4*)(blob + ((mb * 2 + ks2) * 64 + lane) * 16) = w; }
        wave_sync();
    }
}

constexpr int SC_BUF2 = 54272;
__device__ __forceinline__ void ph_gdn_scan(int wv, const Params& p, unsigned char* smem) {
    if (blockIdx.x >= 64) return;
    const int tid = otid(wv), wave = __builtin_amdgcn_readfirstlane(tid >> 6), lane = tid & 63, r = lane & 15, g = lane >> 4;
    const int bh = blockIdx.x >> 1, half = blockIdx.x & 1, b = bh >> 3, h = bh & 7, s = half * 4 + (wave & 3);
    const bf16_t* pq = (const bf16_t*)(p.ws + WS_R1); const float* BA = (const float*)(p.ws + WS_BA); bf16_t* mix = (bf16_t*)(p.ws + WS_MIX);
    const unsigned char* blob0 = (const unsigned char*)p.out + ((size_t)(b * 128) * 8 + h) * 16384;
    LAS unsigned char* lds = (LAS unsigned char*)smem;
    const bool compute = wave < 4;
    const int fsw = ((r & 3) << 2) | (r >> 2);
    const int q4 = r >> 2, p4 = r & 3, ftr = (q4 << 2) | g;
    f32x4 S[8];
#pragma unroll
    for (int i = 0; i < 8; ++i) S[i] = (f32x4){0.f, 0.f, 0.f, 0.f};
#define GDN_ISSUE(nn, bf) do { const size_t t0_ = (size_t)b * SEQ + 64 * (nn); int l_ = lane; asm volatile("" : "+v"(l_)); const int r_ = l_ & 15, g_ = l_ >> 4;     \
        if (wave == 4) { const size_t tok = t0_ + l_; const float beta = BA[tok * 16 + h], gc = BA[tok * 16 + 8 + h], gl = __shfl(gc, 63); LAS float* sc = (LAS float*)(lds + (bf) * SC_BUF2 + 53248); \
            sc[l_] = beta; sc[64 + l_] = __expf(gc); sc[128 + l_] = __expf(gl - gc); if (l_ == 0) sc[192] = __expf(gl); } \
        _Pragma("unroll") for (int ii = 0; ii < 13; ++ii) { const int idx = (wave - 4) * 13 + ii; \
            if (idx < 32) { const int sec = idx < 16 ? 1 : 0, i4 = idx & 15, row = 4 * i4 + g_, ch = r_ ^ (((row & 3) << 2) | ((row >> 2) & 3)); \
                __builtin_amdgcn_global_load_lds((const unsigned*)(pq + (t0_ + row) * 3072 + sec * 1024 + h * 128 + ch * 8), (LAS unsigned*)(lds + (bf) * SC_BUF2 + (sec == 1 ? 0 : 16384) + i4 * 1024), 16, 0, 0); } \
            else if (idx < 44) { const int sl = (idx - 32) % 6, isA = (idx - 32) / 6, fi = sl == 0 ? 0 : (sl == 1 ? 2 : sl + 2); \
                __builtin_amdgcn_global_load_lds((const unsigned*)(blob0 + (size_t)(nn) * 8 * 16384 + isA * 8192 + fi * 1024 + l_ * 16), (LAS unsigned*)(lds + (bf) * SC_BUF2 + 32768 + isA * 6144 + sl * 1024), 16, 0, 0); } \
            else { const int i4 = idx - 44, row = 8 * i4 + (l_ >> 3); \
                __builtin_amdgcn_global_load_lds((const unsigned*)(pq + (t0_ + row) * 3072 + 2048 + h * 128 + half * 64 + (l_ & 7) * 8), (LAS unsigned*)(lds + (bf) * SC_BUF2 + 45056 + i4 * 1024), 16, 0, 0); } } } while (0)
    if (!compute) { GDN_ISSUE(0, 0); GDN_ISSUE(1, 1); asm volatile("s_waitcnt vmcnt(13)" ::: "memory"); }
    __syncthreads();
    for (int n = 0; n < 128; ++n) {
        const int bf = n % 3;
        if (!compute) { if (n + 2 < 128) { GDN_ISSUE(n + 2, (n + 2) % 3); } }
        else {
            const LAS unsigned char* L = lds + bf * SC_BUF2;
            const LAS float* sc = (const LAS float*)(L + 53248);
            bf16x8 fa[16], ft[6];
#pragma unroll
            for (int ks = 0; ks < 4; ++ks)
#pragma unroll
                for (int mb = 0; mb < 4; ++mb) { const int rowoff = (16 * mb + r) * 256, ch1 = 4 * ks + (g >> 1), within = 8 * (g & 1);
                    const u32x2 k1 = *(const LAS u32x2*)(L + rowoff + ((ch1 ^ fsw) << 4) + within), k2 = *(const LAS u32x2*)(L + rowoff + (((ch1 + 2) ^ fsw) << 4) + within);
                    fa[mb * 4 + ks] = __builtin_bit_cast(bf16x8, __builtin_shufflevector(k1, k2, 0, 1, 2, 3)); }
#pragma unroll
            for (int i = 0; i < 6; ++i) ft[i] = *(const LAS bf16x8*)(L + 32768 + (i * 64 + lane) * 16);
            bf16x8 SB[4];
#pragma unroll
            for (int ks = 0; ks < 4; ++ks) SB[ks] = pack8(S[2 * ks], S[2 * ks + 1]);
            __builtin_amdgcn_sched_barrier(0);
            f32x4 KS[4];
#pragma unroll
            for (int mb = 0; mb < 4; ++mb) KS[mb] = (f32x4){0.f, 0.f, 0.f, 0.f};
#pragma unroll
            for (int ks = 0; ks < 4; ++ks)
#pragma unroll
                for (int mb = 0; mb < 4; ++mb) KS[mb] = MFMA16(fa[mb * 4 + ks], SB[ks], KS[mb]);
            f32x4 Vn[4];
            { f32x4 R[4];
#pragma unroll
              for (int mb = 0; mb < 4; ++mb) { const f32x4 be = *(const LAS f32x4*)(sc + 16 * mb + 4 * g), eg = *(const LAS f32x4*)(sc + 64 + 16 * mb + 4 * g);
#pragma unroll
                  for (int jj = 0; jj < 4; ++jj) { const float vv = bf2f(*(const LAS bf16_t*)(L + 45056 + (16 * mb + 4 * g + jj) * 128 + (16 * (wave & 3) + r) * 2)); R[mb][jj] = be[jj] * (vv - eg[jj] * KS[mb][jj]); } }
              bf16x8 RB[2]; RB[0] = pack8(R[0], R[1]); RB[1] = pack8(R[2], R[3]);
#pragma unroll
              for (int mb = 0; mb < 4; ++mb) Vn[mb] = (f32x4){0.f, 0.f, 0.f, 0.f};
#pragma unroll
              for (int ks2 = 0; ks2 < 2; ++ks2)
#pragma unroll
                  for (int mb = 0; mb < 4; ++mb) if (!(ks2 == 1 && mb < 2)) Vn[mb] = MFMA16(ft[mb == 0 ? 0 : (mb == 1 ? 1 : 2 * mb - 2 + ks2)], RB[ks2], Vn[mb]); }
            __builtin_amdgcn_sched_barrier(0);
#pragma unroll
            for (int ks2 = 0; ks2 < 2; ++ks2)
#pragma unroll
                for (int mp = 0; mp < 8; ++mp) {
                    const int row1 = 32 * ks2 + 4 * g + q4, chn = ((2 * mp + (p4 >> 1)) ^ ftr) << 4, wi = 8 * (p4 & 1);
                    const s16x4 lo = __builtin_amdgcn_ds_read_tr16_b64_v4i16((LAS s16x4*)(L + row1 * 256 + chn + wi));
                    const s16x4 hi = __builtin_amdgcn_ds_read_tr16_b64_v4i16((LAS s16x4*)(L + (row1 + 16) * 256 + chn + wi));
                    fa[mp * 2 + ks2] = __builtin_shufflevector(lo, hi, 0, 1, 2, 3, 4, 5, 6, 7); }
            bf16x8 VB[2], VdB[2];
            { VB[0] = pack8(Vn[0], Vn[1]); VB[1] = pack8(Vn[2], Vn[3]);
#pragma unroll
              for (int mb = 0; mb < 4; ++mb) Vn[mb] = *(const LAS f32x4*)(sc + 128 + 16 * mb + 4 * g) * Vn[mb];
              VdB[0] = pack8(Vn[0], Vn[1]); VdB[1] = pack8(Vn[2], Vn[3]); }
            { const float egl = sc[192];
#pragma unroll
              for (int mp = 0; mp < 8; ++mp) S[mp] = S[mp] * egl; }
            __builtin_amdgcn_sched_barrier(0);
#pragma unroll
            for (int ks2 = 0; ks2 < 2; ++ks2)
#pragma unroll
                for (int mp = 0; mp < 8; ++mp) S[mp] = MFMA16(fa[mp * 2 + ks2], VdB[ks2], S[mp]);
            __builtin_amdgcn_sched_barrier(0);
#pragma unroll
            for (int ks = 0; ks < 4; ++ks)
#pragma unroll
                for (int mb = 0; mb < 4; ++mb) { const int rowoff = 16384 + (16 * mb + r) * 256, ch1 = 4 * ks + (g >> 1), within = 8 * (g & 1);
                    const u32x2 q1 = *(const LAS u32x2*)(L + rowoff + ((ch1 ^ fsw) << 4) + within), q2 = *(const LAS u32x2*)(L + rowoff + (((ch1 + 2) ^ fsw) << 4) + within);
                    fa[mb * 4 + ks] = __builtin_bit_cast(bf16x8, __builtin_shufflevector(q1, q2, 0, 1, 2, 3)); }
#pragma unroll
            for (int i = 0; i < 6; ++i) ft[i] = *(const LAS bf16x8*)(L + 38912 + (i * 64 + lane) * 16);
            __builtin_amdgcn_sched_barrier(0);
            f32x4 O[4];
#pragma unroll
            for (int mb = 0; mb < 4; ++mb) O[mb] = (f32x4){0.f, 0.f, 0.f, 0.f};
#pragma unroll
            for (int ks = 0; ks < 4; ++ks)
#pragma unroll
                for (int mb = 0; mb < 4; ++mb) O[mb] = MFMA16(fa[mb * 4 + ks], SB[ks], O[mb]);
#pragma unroll
            for (int mb = 0; mb < 4; ++mb) O[mb] = *(const LAS f32x4*)(sc + 64 + 16 * mb + 4 * g) * O[mb];
#pragma unroll
            for (int ks2 = 0; ks2 < 2; ++ks2)
#pragma unroll
                for (int mb = 0; mb < 4; ++mb) if (!(ks2 == 1 && mb < 2)) O[mb] = MFMA16(ft[mb == 0 ? 0 : (mb == 1 ? 1 : 2 * mb - 2 + ks2)], VB[ks2], O[mb]);
            __builtin_amdgcn_sched_barrier(0);
            const size_t t0 = (size_t)b * SEQ + 64 * n;
#pragma unroll
            for (int mb = 0; mb < 4; ++mb)
#pragma unroll
                for (int jj = 0; jj < 4; ++jj) mix[(t0 + 16 * mb + 4 * g + jj) * 1536 + h * 128 + 16 * s + r] = (bf16_t)(pk2(O[mb][jj], 0.f) & 0xffffu);
        }
        if (!compute) { if (n + 2 < 128) asm volatile("s_waitcnt vmcnt(13)" ::: "memory"); else asm volatile("s_waitcnt vmcnt(0)" ::: "memory"); }
        __syncthreads();
    }
#undef GDN_ISSUE
}

constexpr size_t S5_AALL = 0, S5_ZG = 80 * MiB, S5_BTALL = 144 * MiB, S5_BTE = 184 * MiB, S5_E = 204 * MiB;
__device__ __forceinline__ void sincos_d(double x, double& s, double& c) {
    const double k = __builtin_rint(x * 0.15915494309189535); const double r = x - k * 6.283185307179586476925; const double r2 = r * r;
    double ts = 1.0, ss = 1.0, tc = 1.0, cs = 1.0;
#pragma unroll
    for (int n = 1; n <= 13; ++n) { ts *= -r2 / (double)((2 * n) * (2 * n + 1)); ss += ts; tc *= -r2 / (double)((2 * n - 1) * (2 * n)); cs += tc; }
    s = r * ss; c = cs;
}
__device__ __forceinline__ float gelu_tanh(float x) { const float u = 0.7978845608028654f * (x + 0.044715f * x * x * x); const float t = 1.f - 2.f / (__expf(2.f * u) + 1.f); return 0.5f * x * (1.f + t); }
__device__ __forceinline__ void s5_apow(const Params& p, int j, int g, int pp, int tau, float& ar, float& ai) {
    const size_t gp = ((size_t)j * 64 + g) * 64 + pp; const float are = p.in[16][gp], aim = p.in[17][gp], dt = __expf(p.in[22][j * 64 + g]);
    const float m = expf(are * dt * (float)tau); double sd, cd; sincos_d((double)aim * (double)dt * (double)tau, sd, cd); ar = m * (float)cd; ai = m * (float)sd;
}
__device__ __forceinline__ void ph_s5_build(int wv, const Params& p, int j, unsigned char* smem, int blk0, int nblk, bool tables) {
    float* Apr = (float*)smem; float* Api = Apr + 33 * 64; float* Bbr = Api + 33 * 64; float* Bbi = Bbr + 1024; float* Ccr = Bbi + 1024; float* Cci = Ccr + 1024; float* Kt = Cci + 1024;
    bf16_t* AALL = (bf16_t*)(p.ws + WS_R1 + S5_AALL); bf16_t* BTALL = (bf16_t*)((unsigned char*)p.out + 64 * MiB); bf16_t* BTE = (bf16_t*)((unsigned char*)p.out + 104 * MiB);
    const int tid = otid(wv);
    if (!tables) { for (int c = blockIdx.x * 512 + tid; c < 65536 * 16; c += gridDim.x * 512) { const int rr = c >> 4, ch = c & 15; unsigned zz = 0u; asm volatile("" : "+v"(zz)); u32x4 z = {zz, zz, zz, zz}; *(u32x4*)(AALL + ((size_t)rr * 640 + 512 + ch * 8)) = z; } return; }
    if ((int)blockIdx.x < blk0) return;
    for (int job = (int)blockIdx.x - blk0; job < 256; job += nblk) {
        const int g = job >> 2, q = job & 3;
        __syncthreads();
        for (int e = tid; e < 33 * 64; e += 512) { float ar, ai; s5_apow(p, j, g, e & 63, e >> 6, ar, ai); Apr[e] = ar; Api[e] = ai; }
        for (int e = tid; e < 1024; e += 512) { const int i = e >> 6, pp = e & 63; const size_t o = (((size_t)j * 64 + g) * 16 + i) * 64 + pp; Ccr[e] = p.in[20][o]; Cci[e] = p.in[21][o]; }
        __syncthreads();
        for (int e = tid; e < 1024; e += 512) { const int pp = e >> 4, i = e & 15; const size_t gp = ((size_t)j * 64 + g) * 64 + pp; const float are = p.in[16][gp], aim = p.in[17][gp];
            const float abr = Apr[64 + pp], abi = Api[64 + pp], den = are * are + aim * aim, nre = abr - 1.f, nim = abi;
            const float fre = (nre * are + nim * aim) / den, fim = (nim * are - nre * aim) / den; const float br = p.in[18][gp * 16 + i], bi = p.in[19][gp * 16 + i];
            Bbr[e] = fre * br - fim * bi; Bbi[e] = fre * bi + fim * br; }
        __syncthreads();
        { const int tau = tid >> 4, i = tid & 15; float acc[16];
#pragma unroll
          for (int ip = 0; ip < 16; ++ip) acc[ip] = 0.f;
          for (int pp = 0; pp < 64; ++pp) { const float cr = Ccr[i * 64 + pp], ci = Cci[i * 64 + pp], ar = Apr[tau * 64 + pp], ai = Api[tau * 64 + pp]; const float car = cr * ar - ci * ai, cai = cr * ai + ci * ar;
#pragma unroll
              for (int q4 = 0; q4 < 4; ++q4) { const f32x4 br = *(const f32x4*)(Bbr + pp * 16 + q4 * 4), bi = *(const f32x4*)(Bbi + pp * 16 + q4 * 4);
#pragma unroll
                  for (int k = 0; k < 4; ++k) acc[q4 * 4 + k] += car * br[k] - cai * bi[k]; } }
#pragma unroll
          for (int ip = 0; ip < 16; ++ip) Kt[tau * 256 + i * 16 + ip] = acc[ip]; }
        __syncthreads();
        for (int c = tid; c < 128 * 80; c += 512) { const int rloc = c / 80, ch = c - rloc * 80, t = 8 * q + (rloc >> 4), i = rloc & 15, col0 = ch * 8; float v[8];
            if (col0 < 512) { const int s = col0 >> 4, i0 = col0 & 15;
#pragma unroll
                for (int e = 0; e < 8; ++e) v[e] = s <= t ? Kt[(t - s) * 256 + i * 16 + i0 + e] : 0.f; }
            else {
#pragma unroll
                for (int e = 0; e < 8; ++e) { const int pc = col0 - 512 + e, pp = pc & 63; const float cr = Ccr[i * 64 + pp], ci = Cci[i * 64 + pp], ar = Apr[(t + 1) * 64 + pp], ai = Api[(t + 1) * 64 + pp];
                    v[e] = pc < 64 ? cr * ar - ci * ai : -(cr * ai + ci * ar); } }
            u32x4 w; w.x = pk2(v[0], v[1]); w.y = pk2(v[2], v[3]); w.z = pk2(v[4], v[5]); w.w = pk2(v[6], v[7]);
            *(u32x4*)(BTALL + ((size_t)(g * 512 + t * 16 + i) * 640 + col0)) = w; }
        for (int c = tid; c < 64 * 80; c += 512) { const int rr = c / 80, ch = c - rr * 80, col0 = ch * 8; float v[8];
#pragma unroll
            for (int e = 0; e < 8; ++e) v[e] = 0.f;
            if (q < 2 && col0 < 512) { const int s = col0 >> 4, i0 = col0 & 15; const float ar = Apr[(31 - s) * 64 + rr], ai = Api[(31 - s) * 64 + rr];
#pragma unroll
                for (int e = 0; e < 8; ++e) { const float br = Bbr[rr * 16 + i0 + e], bi = Bbi[rr * 16 + i0 + e]; v[e] = q == 0 ? ar * br - ai * bi : ar * bi + ai * br; } }
            u32x4 w; w.x = pk2(v[0], v[1]); w.y = pk2(v[2], v[3]); w.z = pk2(v[4], v[5]); w.w = pk2(v[6], v[7]);
            *(u32x4*)(BTE + ((size_t)(g * 256 + 64 * q + rr) * 640 + col0)) = w; }
    }
}
__device__ __forceinline__ void ph_s5_carry(int wv, const Params& p, int j, float* ldsf) {
    const int tid = otid(wv), pp = tid & 63, seg = tid >> 6;
    for (int gb = blockIdx.x; gb < 256; gb += gridDim.x) {
        const int g = gb >> 2, b = gb & 3;
        float ar, ai; s5_apow(p, j, g, pp, 32, ar, ai);
        const float* E = (const float*)(p.ws + WS_R1 + S5_E) + (size_t)(g * 1024 + b * 256 + seg * 32) * 128; bf16_t* A = (bf16_t*)(p.ws + WS_R1 + S5_AALL) + (size_t)(g * 1024 + b * 256 + seg * 32) * 640 + 512;
        float er[32], ei[32];
#pragma unroll
        for (int k = 0; k < 32; ++k) { er[k] = E[(size_t)k * 128 + pp]; ei[k] = E[(size_t)k * 128 + 64 + pp]; }
        float hr = 0.f, hi = 0.f, pr = 1.f, pi = 0.f;
#pragma unroll
        for (int k = 0; k < 32; ++k) { const float nr = ar * hr - ai * hi + er[k], ni = ar * hi + ai * hr + ei[k]; hr = nr; hi = ni; const float qr = pr * ar - pi * ai, qi = pr * ai + pi * ar; pr = qr; pi = qi; }
        __syncthreads();
        ldsf[tid] = hr; ldsf[512 + tid] = hi;
        __syncthreads();
        float sr = 0.f, si = 0.f;
        for (int s2 = 0; s2 < seg; ++s2) { const float lr = ldsf[s2 * 64 + pp], li = ldsf[512 + s2 * 64 + pp]; const float nr = pr * sr - pi * si + lr, ni = pr * si + pi * sr + li; sr = nr; si = ni; }
        hr = sr; hi = si;
#pragma unroll
        for (int k = 0; k < 32; ++k) { A[(size_t)k * 640 + pp] = (bf16_t)(pk2(hr, 0.f) & 0xffffu); A[(size_t)k * 640 + 64 + pp] = (bf16_t)(pk2(hi, 0.f) & 0xffffu);
            const float nr = ar * hr - ai * hi + er[k], ni = ar * hi + ai * hr + ei[k]; hr = nr; hi = ni; }
    }
}
struct S5SchedE { int G, c, wv; __device__ __forceinline__ bool next(int i, Unit& u) const { const int L = i * G + c; if (L >= 256) return false; u.pm = L; u.pn = L >> 2; u.aux = 0; return true; }
    __device__ __forceinline__ void a_ready(const Unit&) const {} __device__ __forceinline__ void done(const Unit&) const {} };
struct S5SchedM { int G, c, wv; __device__ __forceinline__ bool next(int i, Unit& u) const { const int L = i * G + c; if (L >= 512) return false; const int g = L >> 3; u.pm = g * 4 + ((L >> 1) & 3); u.pn = g * 2 + (L & 1); u.aux = 0; return true; }
    __device__ __forceinline__ void a_ready(const Unit&) const {} __device__ __forceinline__ void done(const Unit&) const {} };
struct EpiS5E {
    static constexpr bool PERM = false, AFTER_DRAIN = false; float* E;
    __device__ __forceinline__ void operator()(const f32x4 (&acc)[2][2][4][2], const Unit& u, int wr, int wc, int fr, int fq) const {
        const int row0 = u.pm * 256 + wr * 64 + fr, col0 = wc * 32 + 4 * fq;
#pragma unroll
        for (int ai = 0; ai < 2; ++ai)
#pragma unroll
            for (int m = 0; m < 4; ++m)
#pragma unroll
                for (int n = 0; n < 2; ++n) *(f32x4*)(E + (size_t)(row0 + ai * 128 + m * 16) * 128 + col0 + n * 16) = acc[ai][0][m][n];
    }
};
struct EpiS5M {
    static constexpr bool PERM = true, AFTER_DRAIN = false; const bf16_t* AALL; bf16_t* ZG; const float* dsk;
    __device__ __forceinline__ void operator()(const f32x4 (&acc)[2][2][4][2], const Unit& u, int wr, int wc, int fr, int fq) const {
        const int row0 = u.pm * 256 + wr * 64 + fr, colb = u.pn * 256 + wc * 32 + 8 * fq;
#pragma unroll
        for (int ai = 0; ai < 2; ++ai)
#pragma unroll
            for (int m = 0; m < 4; ++m) { const int row = row0 + ai * 128 + m * 16, g = row >> 10, rowl = row & 1023;
#pragma unroll
                for (int bj = 0; bj < 2; ++bj) { const int cl = colb + bj * 128 - g * 512, t = cl >> 4, i0 = cl & 15; const size_t tok = (size_t)rowl * 32 + t;
                    const u32x4 uu = *(const u32x4*)(AALL + (size_t)row * 640 + t * 16 + i0); const f32x4 d0 = *(const f32x4*)(dsk + g * 16 + i0), d1 = *(const f32x4*)(dsk + g * 16 + i0 + 4);
                    const f32x4 v0 = acc[ai][bj][m][0], v1 = acc[ai][bj][m][1]; u32x4 w;
                    w.x = pk2(gelu_tanh(v0[0] + d0[0] * bflo(uu.x)), gelu_tanh(v0[1] + d0[1] * bfhi(uu.x))); w.y = pk2(gelu_tanh(v0[2] + d0[2] * bflo(uu.y)), gelu_tanh(v0[3] + d0[3] * bfhi(uu.y)));
                    w.z = pk2(gelu_tanh(v1[0] + d1[0] * bflo(uu.z)), gelu_tanh(v1[1] + d1[1] * bfhi(uu.z))); w.w = pk2(gelu_tanh(v1[2] + d1[2] * bflo(uu.w)), gelu_tanh(v1[3] + d1[3] * bfhi(uu.w)));
                    *(u32x4*)(ZG + tok * 1024 + g * 16 + i0) = w; } }
    }
};
template <class Epi, class Sched> __device__ __forceinline__ void run_gemm_s(int wv, LAS unsigned char* lds, const bf16_t* A, const bf16_t* Bt, int M, int N, int K, const Epi& E) {
    pg8::Gemm g; g.A = A; g.Bt = Bt; g.M = M; g.N = N; g.K = K;
    Sched S; S.G = (int)gridDim.x; S.c = (int)blockIdx.x; S.wv = wv;
    pg8::gemm_phase<Epi, Sched, false>(lds, g, S, E, nullptr);
}

constexpr size_t WS_KMEM = 35 * MiB, WS_VT = 36 * MiB;
struct OffSched { int base, cnt, nN, wv; __device__ __forceinline__ bool next(int i, Unit& u) const { const int L = (int)blockIdx.x - base; if (i > 0 || L < 0 || L >= cnt) return false; u.pm = L / nN; u.pn = L % nN; u.aux = 0; return true; }
    __device__ __forceinline__ void a_ready(const Unit&) const {} __device__ __forceinline__ void done(const Unit&) const {} };
struct EpiPlain { static constexpr bool PERM = true, AFTER_DRAIN = false; bf16_t* O; int ld;
    __device__ __forceinline__ void operator()(const f32x4 (&acc)[2][2][4][2], const Unit& u, int wr, int wc, int fr, int fq) const {
        const int row0 = u.pm * 256 + wr * 64 + fr, colb = u.pn * 256 + wc * 32 + 8 * fq;
#pragma unroll
        for (int ai = 0; ai < 2; ++ai)
#pragma unroll
            for (int m = 0; m < 4; ++m)
#pragma unroll
                for (int bj = 0; bj < 2; ++bj) { const f32x4 v0 = acc[ai][bj][m][0], v1 = acc[ai][bj][m][1]; u32x4 w; w.x = pk2(v0[0], v0[1]); w.y = pk2(v0[2], v0[3]); w.z = pk2(v1[0], v1[1]); w.w = pk2(v1[2], v1[3]);
                    *(u32x4*)(O + (size_t)(row0 + ai * 128 + m * 16) * ld + colb + bj * 128) = w; }
    }
};
__device__ __forceinline__ void ph_xattn(int wv, const Params& p, unsigned char* smem, int blk0 = 0, int nblk = 0, const bool dry = false) {
    const int tid = otid(wv), wave = __builtin_amdgcn_readfirstlane(tid >> 6), lane = tid & 63, r = lane & 15, g = lane >> 4;
    const bf16_t* Kg = (const bf16_t*)(p.ws + WS_KMEM); const bf16_t* Vg = (const bf16_t*)(p.ws + WS_VT); bf16_t* mix = (bf16_t*)(p.ws + WS_MIX);
    LAS unsigned char* lds = (LAS unsigned char*)smem;
    if (nblk == 0) nblk = (int)gridDim.x;
    if ((int)blockIdx.x < blk0) return;
    for (int vb = (int)blockIdx.x - blk0; vb < 256; vb += nblk) {
        const int b = vb >> 6, h = (vb >> 4) & 3, tb = vb & 15;
        __syncthreads();
#pragma unroll
        for (int ii = 0; ii < 8; ++ii) { const int i = wave * 8 + ii; const int row = 4 * i + g, ch = r ^ (row & 15);
            __builtin_amdgcn_global_load_lds((const unsigned*)(Kg + (size_t)(b * 256 + row) * 512 + h * 128 + ch * 8), (LAS unsigned*)(lds + i * 1024), 16, 0, 0); }
#pragma unroll
        for (int ii = 0; ii < 8; ++ii) { const int i = wave * 8 + ii; const int row = 2 * i + (lane >> 5), ch = (lane & 31) ^ (row & 15);
            __builtin_amdgcn_global_load_lds((const unsigned*)(Vg + (size_t)(h * 128 + row) * 1024 + b * 256 + ch * 8), (LAS unsigned*)(lds + 65536 + i * 1024), 16, 0, 0); }
        asm volatile("s_waitcnt vmcnt(0)" ::: "memory");
        __syncthreads();
#pragma unroll 1
        for (int it = 0; it < 4; ++it) {
            const size_t tok0 = (size_t)b * SEQ + tb * 512 + (wave * 4 + it) * 16;
            bf16_t* qp = mix + (tok0 + r) * 1536 + 1024 + h * 128;
            bf16x8 qf[4];
#pragma unroll
            for (int ks = 0; ks < 4; ++ks) qf[ks] = *(const bf16x8*)(qp + 32 * ks + 8 * g);
            f32x4 St[16];
#pragma unroll
            for (int kb = 0; kb < 16; ++kb) { St[kb] = (f32x4){0.f, 0.f, 0.f, 0.f};
#pragma unroll
                for (int ks = 0; ks < 4; ++ks) St[kb] = MFMA16(*(const LAS bf16x8*)(lds + (16 * kb + r) * 256 + (((4 * ks + g) ^ r) << 4)), qf[ks], St[kb]);
                __builtin_amdgcn_sched_barrier(0); }
            float mx = -3.0e38f;
#pragma unroll
            for (int kb = 0; kb < 16; ++kb)
#pragma unroll
                for (int jj = 0; jj < 4; ++jj) mx = fmaxf(mx, St[kb][jj]);
            mx = fmaxf(mx, __shfl_xor(mx, 16)); mx = fmaxf(mx, __shfl_xor(mx, 32));
            float sum = 0.f;
#pragma unroll
            for (int kb = 0; kb < 16; ++kb)
#pragma unroll
                for (int jj = 0; jj < 4; ++jj) { const float e = __expf((St[kb][jj] - mx) * 0.08838834764831845f); St[kb][jj] = e; sum += e; }
            sum += __shfl_xor(sum, 16); sum += __shfl_xor(sum, 32);
            const float inv = 1.f / sum;
            bf16x8 PB[8];
#pragma unroll
            for (int k2 = 0; k2 < 8; ++k2) PB[k2] = pack8(St[2 * k2], St[2 * k2 + 1]);
#pragma unroll
            for (int db = 0; db < 8; ++db) { f32x4 O = {0.f, 0.f, 0.f, 0.f};
#pragma unroll
                for (int k2 = 0; k2 < 8; ++k2) { const int rowoff = 65536 + (16 * db + r) * 512, ch1 = 4 * k2 + (g >> 1), o8 = 8 * (g & 1);
                    const u32x2 v1 = *(const LAS u32x2*)(lds + rowoff + ((ch1 ^ r) << 4) + o8), v2 = *(const LAS u32x2*)(lds + rowoff + (((ch1 + 2) ^ r) << 4) + o8);
                    u32x4 vw; vw.x = v1.x; vw.y = v1.y; vw.z = v2.x; vw.w = v2.y;
                    O = MFMA16(__builtin_bit_cast(bf16x8, vw), PB[k2], O); }
                u32x2 ow; ow.x = pk2(O[0] * inv, O[1] * inv); ow.y = pk2(O[2] * inv, O[3] * inv);
                if (!dry) *(u32x2*)(qp + 16 * db + 4 * g) = ow; else if (ow.x == 0x12345u) qp[0] = 1;
                __builtin_amdgcn_sched_barrier(0); }
        }
    }
}

#define XB_TMO      128
#define XB_XCNT(j)  (256  + 64 * (j))
#define XB_XSUB(j)  (1280 + 64 * (j))
#define XB_XGEN(j)  (2304 + 64 * (j))
#define XB_TOP      3328
#define XB_TOPGEN   3392
#define XCD_BAR_WORDS 3456
#define XB_SPIN_CAP (1u << 18)

__device__ __forceinline__ unsigned xb_ld(unsigned* p)              { return __hip_atomic_load(p, __ATOMIC_RELAXED, __HIP_MEMORY_SCOPE_AGENT); }
__device__ __forceinline__ unsigned xb_add(unsigned* p, unsigned v) { return __hip_atomic_fetch_add(p, v, __ATOMIC_RELAXED, __HIP_MEMORY_SCOPE_AGENT); }
__device__ __forceinline__ unsigned xb_xcc_id() { return (unsigned)__builtin_amdgcn_s_getreg((3 << 11) | 20) & 0xFu; }
#define XB_SPIN(cond, bar) do { unsigned _sp = 0; while (cond) { __builtin_amdgcn_s_sleep(1); \
    if ((++_sp & 255u) == 0u) { if (xb_ld(&(bar)[XB_TMO])) break; if (_sp > XB_SPIN_CAP) { atomicAdd(&(bar)[XB_TMO], 1u); break; } } } } while (0)

struct XcdBarrier {
    unsigned* bar; unsigned x; int wv;
    volatile LAS unsigned* st;
};

__device__ __forceinline__ XcdBarrier xcd_barrier_post(unsigned* bar, volatile LAS unsigned* st) {
    XcdBarrier b; b.bar = bar; b.x = xb_xcc_id(); b.st = st;
    if (threadIdx.x == 0) (void)xb_add(&bar[XB_XCNT(b.x)], 1u);
    return b;
}
__device__ __forceinline__ void xcd_barrier_complete(unsigned* bar, unsigned x, unsigned& nloc, unsigned& nx) {
    const unsigned G = gridDim.x * gridDim.y * gridDim.z;
    unsigned sum, cnt, mine, sp = 0u;
    for (;;) {
        sum = 0u; cnt = 0u; mine = 0u;
#pragma unroll
        for (unsigned j = 0; j < 16; ++j) { const unsigned c = xb_ld(&bar[XB_XCNT(j)]); sum += c; cnt += (c > 0u) ? 1u : 0u; mine = (j == x) ? c : mine; }
        if (sum == G) break;
        __builtin_amdgcn_s_sleep(1);
        if ((++sp & 255u) == 0u) { if (xb_ld(&bar[XB_TMO])) break; if (sp > XB_SPIN_CAP) { atomicAdd(&bar[XB_TMO], 1u); break; } }
    }
    nloc = mine > 0u ? mine : 1u; nx = cnt > 0u ? cnt : 1u;
}

__device__ __forceinline__ void xcd_barrier(const XcdBarrier& b) {
    asm volatile("s_waitcnt vmcnt(0)" ::: "memory");
    __syncthreads();
    unsigned xm_ = ~0u; asm volatile("" : "+s"(xm_));
    if (b.wv == 0 && __builtin_amdgcn_mbcnt_hi(xm_, __builtin_amdgcn_mbcnt_lo(xm_, 0u)) == 0u) {
        unsigned* bar = b.bar;
        __builtin_amdgcn_s_waitcnt(0);
        unsigned nloc = b.st[0], nx = b.st[1];
        if (nloc == 0u) { xcd_barrier_complete(bar, b.x, nloc, nx); b.st[0] = nloc; b.st[1] = nx; }
        const unsigned old = xb_add(&bar[XB_XSUB(b.x)], 1u);
        const unsigned gen = old / nloc;
        if (old + 1u == (gen + 1u) * nloc) {
            __builtin_amdgcn_fence(__ATOMIC_RELEASE, "agent");
            asm volatile("s_waitcnt vmcnt(0)" ::: "memory");
            const unsigned og = xb_add(&bar[XB_TOP], 1u);
            const unsigned tg = og / nx;
            if (og + 1u == (tg + 1u) * nx) xb_add(&bar[XB_TOPGEN], 1u);
            else XB_SPIN(xb_ld(&bar[XB_TOPGEN]) == tg, bar);
            __builtin_amdgcn_fence(__ATOMIC_ACQUIRE, "agent");
            xb_add(&bar[XB_XGEN(b.x)], 1u);
            asm volatile("s_waitcnt vmcnt(0)" ::: "memory");
        } else {
            XB_SPIN(xb_ld(&bar[XB_XGEN(b.x)]) == gen, bar);
            __builtin_amdgcn_fence(__ATOMIC_ACQUIRE, "agent");
            asm volatile("s_waitcnt vmcnt(0)" ::: "memory");
        }
    }
    __syncthreads();
}


__global__ void __launch_bounds__(512) fwd_mega(Params p) {
    extern __shared__ __attribute__((aligned(16))) unsigned char shm[];
    LAS unsigned char* lds = (LAS unsigned char*)shm; float* ldsf = (float*)shm;
    cg::grid_group grid = cg::this_grid();
    const int wv = __builtin_amdgcn_readfirstlane((int)threadIdx.x >> 6);
    unsigned char* ws = p.ws;
    bf16_t* XB = (bf16_t*)(ws + WS_XB); bf16_t* MIX = (bf16_t*)(ws + WS_MIX); bf16_t* R1 = (bf16_t*)(ws + WS_R1);
    volatile LAS unsigned* bst = (volatile LAS unsigned*)(lds + LDS_BYTES - 16);
    if (threadIdx.x == 0) { bst[0] = 0u; bst[1] = 0u; }
    __syncthreads();
    XcdBarrier xb = xcd_barrier_post((unsigned*)(ws + WS_BAR), bst); xb.wv = wv;
    for (int ph = p.ph_lo; ph < p.ph_hi; ++ph) {
#ifdef REP_SUB
        const int layer = ph / (NPH + 1), sub0 = ph % (NPH + 1), sub = sub0 <= REP_SUB ? sub0 : sub0 - 1, j = layer >> 1; const bool gdn = (layer & 1) == 0;
        if (sub0 == REP_SUB + 1 && REP_SUB == 4 && gdn) continue;
#else
        const int layer = ph / NPH, sub = ph % NPH, j = layer >> 1; const bool gdn = (layer & 1) == 0;
#endif
        if ((sub == 5 && gdn) || (sub == 0 && layer > 0) || sub == 7 || (sub == 10 && layer < 3) || (sub == 3 && !gdn && gridDim.x == 256)) continue;
        float* CS = (float*)(ws + WS_CSUM); float* STPA = (float*)(ws + WS_STPA); float* STPB = (float*)(ws + WS_STPB);
        if (sub == 0) { cvt_rows(wv, p.in[0], XB, (size_t)T_TOK * DM); cvt_rows(wv, p.in[1], (bf16_t*)(ws + WS_MEMB), (size_t)1024 * 1024);
            ph_convert_in(wv, p, 0, ldsf); }
        else if (sub == 1) {
            if (layer > 0) csum_finalize(wv, CS + ((layer & 1) ? 89600 : 38912), CS + ((layer & 1) ? 105984 : 55296), CS + 81408, CS + 85504, 4096);
            if (gdn) { EpiRoute<0> E; E.o0 = R1; E.o1 = (bf16_t*)(ws + WS_HALO); E.o2 = MIX; E.ba = (float*)(ws + WS_BA); E.zg = (const bf16_t*)(ws + WS_R1 + 192 * MiB); E.bias = nullptr;
                E.stp = layer > 0 ? STPB : nullptr; E.c1 = CS + 71680; E.c2 = CS + 76544; E.sl = lds;
                run_gemm_st(wv, lds, XB, (const bf16_t*)(ws + WS_W_IN), T_TOK, 4864, 1024, E, E.stp); }
            else { EpiRoute<1> E; E.o0 = (bf16_t*)(ws + WS_R1 + S5_AALL); E.o1 = nullptr; E.o2 = MIX; E.ba = nullptr; E.zg = nullptr; E.bias = nullptr; E.stp = STPB; E.c1 = CS + 71680; E.c2 = CS + 76544; E.sl = lds;
                run_gemm_st(wv, lds, XB, (const bf16_t*)(ws + WS_W_IN), T_TOK, 1536, 1024, E, E.stp); }
            { EpiPlain E; E.O = (bf16_t*)(ws + WS_KMEM); E.ld = 512; pg8::Gemm gg; gg.A = (const bf16_t*)(ws + WS_MEMB); gg.Bt = (const bf16_t*)(ws + WS_W_KV); gg.M = 1024; gg.N = 512; gg.K = 1024;
                OffSched S; S.base = (gdn && gridDim.x == 256) ? 128 : 0; S.cnt = 8; S.nN = 2; S.wv = wv; pg8::gemm_phase<EpiPlain, OffSched, false>(lds, gg, S, E, nullptr); }
            { EpiPlain E; E.O = (bf16_t*)(ws + WS_VT); E.ld = 1024; pg8::Gemm gg; gg.A = (const bf16_t*)(ws + WS_W_KV) + (size_t)512 * 1024; gg.Bt = (const bf16_t*)(ws + WS_MEMB); gg.M = 512; gg.N = 1024; gg.K = 1024;
                OffSched S; S.base = (gdn && gridDim.x == 256) ? 136 : 8; S.cnt = 8; S.nN = 4; S.wv = wv; pg8::gemm_phase<EpiPlain, OffSched, false>(lds, gg, S, E, nullptr); }
            if (!gdn) ph_s5_build(wv, p, j, shm, 0, 0, false);
        } else if (sub == 2) {
            if (gdn) ph_gdn_prep(wv, p, j, shm);
            else { EpiS5E E; E.E = (float*)(ws + WS_R1 + S5_E); run_gemm_s<EpiS5E, S5SchedE>(wv, lds, (const bf16_t*)(ws + WS_R1 + S5_AALL), (const bf16_t*)((unsigned char*)p.out + 104 * MiB), 65536, 16384, 640, E);
                if (gridDim.x == 256) { asm volatile("s_waitcnt vmcnt(0)" ::: "memory"); __syncthreads(); ph_s5_carry(wv, p, j, ldsf); } }
            if (!gdn) { __syncthreads(); ph_xattn(wv, p, shm);
                if (layer < 3) { __syncthreads(); ph_convert_in(wv, p, layer + 1, ldsf); ph_convert_wo(wv, p, layer + 1, ldsf); ph_convert_w1(wv, p, layer + 1, ldsf); ph_convert_w2(wv, p, layer + 1, ldsf); } }
        } else if (sub == 3) { if (gdn) { ph_gdn_scan(wv, p, shm); __syncthreads(); ph_xattn(wv, p, shm, 64, (int)gridDim.x - 64); }
            else if (gridDim.x != 256) ph_s5_carry(wv, p, j, ldsf);
            if (layer < 3 && gdn) { const int cb0 = (gdn && gridDim.x > 64) ? 64 : 0, cnb = (int)gridDim.x - cb0;
                __syncthreads();
                if (layer == 0) { ph_convert_wo(wv, p, 0, ldsf, cb0, cnb); ph_convert_w1(wv, p, 0, ldsf, cb0, cnb); ph_convert_w2(wv, p, 0, ldsf, cb0, cnb); }
                ph_convert_in(wv, p, layer + 1, ldsf, cb0, cnb); ph_convert_wo(wv, p, layer + 1, ldsf, cb0, cnb); ph_convert_w1(wv, p, layer + 1, ldsf, cb0, cnb); ph_convert_w2(wv, p, layer + 1, ldsf, cb0, cnb);
                if (gdn) { __syncthreads(); ph_s5_build(wv, p, (layer + 1) >> 1, shm, cb0, cnb, true); } } }
        else if (sub == 4) {
            if (layer == 0) csum_finalize(wv, CS + 38912, CS + 55296, CS + 81408, CS + 85504, 4096);
            if (layer < 3) csum_finalize(wv, CS, CS + 19456, CS + 71680, CS + 76544, (layer & 1) ? 4864 : 1536);
            if (gdn) ph_gdn_gnorm(wv, p, j);
            else { EpiS5M E; E.AALL = (const bf16_t*)(ws + WS_R1 + S5_AALL); E.ZG = (bf16_t*)(ws + WS_R1 + S5_ZG); E.dsk = p.in[23] + (size_t)j * 1024;
                run_gemm_s<EpiS5M, S5SchedM>(wv, lds, (const bf16_t*)(ws + WS_R1 + S5_AALL), (const bf16_t*)((unsigned char*)p.out + 64 * MiB), 65536, 32768, 640, E); }
        } else if (sub == 5) {
            { EpiRoute<4> E; E.o0 = nullptr; E.o1 = nullptr; E.o2 = MIX; E.ba = nullptr; E.zg = (const bf16_t*)(ws + WS_R1 + S5_ZG); E.bias = p.in[25] + (size_t)j * 1024;
                run_gemm(wv, lds, (const bf16_t*)(ws + WS_R1 + S5_ZG), (const bf16_t*)(ws + WS_GLU), T_TOK, 1024, 1024, E); }
        } else if (sub == 6) { EpiRes E; E.res = layer == 0 ? p.in[0] : nullptr; E.g = p.in[6] + (layer > 0 ? layer - 1 : 0) * 1024; E.b = p.in[7] + (layer > 0 ? layer - 1 : 0) * 1024; E.yb = XB; E.stp_out = STPA; E.sl = lds;
            run_gemm_st(wv, lds, MIX, (const bf16_t*)(ws + wofs(layer, WS_W_O, 0)), T_TOK, 1024, 1536, E, layer == 0 ? nullptr : STPB); }
        else if (sub == 8) { EpiRoute<2> E; E.o0 = R1; E.o1 = nullptr; E.o2 = nullptr; E.ba = nullptr; E.zg = nullptr; E.bias = nullptr; E.stp = STPA; E.c1 = CS + 81408; E.c2 = CS + 85504; E.sl = lds;
            run_gemm_st(wv, lds, XB, (const bf16_t*)(ws + wofs(layer, WS_W1, 3 * MiB)), T_TOK, 4096, 1024, E, STPA); }
        else if (sub == 9) { EpiRes E; E.res = nullptr; E.g = p.in[4] + layer * 1024; E.b = p.in[5] + layer * 1024; E.yb = XB; E.stp_out = STPB; E.sl = lds;
            run_gemm_st(wv, lds, R1, (const bf16_t*)(ws + wofs(layer, WS_W2, 11 * MiB)), T_TOK, 1024, 4096, E, STPA); }
        else ph_ln_final(wv, XB, p.out, p.in[6] + layer * 1024, p.in[7] + layer * 1024);
        if (ph + 1 < p.ph_hi) { if (ph == p.ph_lo) grid.sync(); else xcd_barrier(xb); }
    }
}

extern "C" void kernel_launch(void* const* d_in, const int* in_sizes, int n_in, void* d_out, int out_size, void* d_ws, size_t ws_size, hipStream_t stream) {
    static int grid = 0;
    if (grid == 0) {
        int dev = 0, cus = 0, per_cu = 0;
        hipGetDevice(&dev); hipDeviceGetAttribute(&cus, hipDeviceAttributeMultiprocessorCount, dev);
        if (hipFuncSetAttribute((const void*)fwd_mega, hipFuncAttributeMaxDynamicSharedMemorySize, LDS_BYTES) != hipSuccess) fprintf(stderr, "hipFuncSetAttribute failed\n");
        hipOccupancyMaxActiveBlocksPerMultiprocessor(&per_cu, (const void*)fwd_mega, 512, LDS_BYTES);
        if (per_cu < 1) { fprintf(stderr, "occupancy query says %d\n", per_cu); per_cu = 1; }
        (void)hipGetLastError();
        grid = cus;
        if (ws_size < 512 * MiB) fprintf(stderr, "workspace too small: %zu\n", ws_size);
    }
    (void)hipMemsetAsync((unsigned char*)d_ws + WS_BAR, 0, XCD_BAR_WORDS * 4, stream);
    Params p{};
    for (int i = 0; i < 26; ++i) p.in[i] = (const float*)d_in[i];
    p.out = (float*)d_out; p.ws = (unsigned char*)d_ws; p.ph_lo = 0;
#ifdef REP_SUB
    p.ph_hi = 4 * (NPH + 1);
#else
    p.ph_hi = 4 * NPH;
#endif
    void* args[] = {&p};
    hipError_t e = hipLaunchCooperativeKernel((const void*)fwd_mega, dim3(grid), dim3(512), args, LDS_BYTES, stream);
    if (e != hipSuccess) fprintf(stderr, "cooperative launch failed: %s (grid %d)\n", hipGetErrorString(e), grid);
}
```

```cpp
#include <hip/hip_runtime.h>
#include <hip/hip_cooperative_groups.h>
#include <cstdio>
namespace cg = cooperative_groups;
namespace pg8 {
#define PG8_LAS __attribute__((address_space(3)))
typedef unsigned short bf16_t;
typedef short bf16x8 __attribute__((ext_vector_type(8)));
typedef float f32x4 __attribute__((ext_vector_type(4)));
typedef unsigned u32x4 __attribute__((ext_vector_type(4)));
constexpr int BM = 256, BK = 64, HALF = 128, HTB = HALF * BK * 2  , STAGE_BYTES = 8 * HTB, NXCD = 8, WGM = 8;

__host__ __device__ __forceinline__ int lds_byte(int r, int c) { const int st = (r >> 4) * 2 + (c >> 5), rr = r & 15, cc = c & 31, ob = rr * 64 + cc * 2; return st * 1024 + (ob ^ (((ob >> 9) & 1) << 5)); }
__host__ __device__ __forceinline__ void stage_rc(int b, int& R, int& C) { const int st = b / 1024, sb = b % 1024, swz = sb ^ (((sb >> 9) & 1) << 5); R = (st >> 1) * 16 + swz / 64; C = (st & 1) * 32 + (swz % 64) / 2; }
__host__ __device__ __forceinline__ int perm32(int rho) { const int n = rho >> 4, i = rho & 15; return 8 * (i >> 2) + 4 * n + (i & 3); }

struct Unit { int pm, pn, aux; };
struct Gemm { const bf16_t* A; const bf16_t* Bt; int M, N, K; };

struct StaticOrder {
    int nM, nN, nwg, G, c, wv;
    __host__ __device__ void init(int M, int N, int G_, int c_) { nM = M / BM; nN = N / BM; nwg = nM * nN; G = G_; c = c_; }
    __host__ __device__ bool next(int i, Unit& u) const {
        const long L = (long)i * G + c; if (L >= nwg) return false;
        int wgid = (int)L; { const int q = nwg / NXCD, r = nwg % NXCD, xcd = wgid % NXCD, off = wgid / NXCD; wgid = (xcd < r ? xcd * (q + 1) : r * (q + 1) + (xcd - r) * q) + off; }
        const int nig = WGM * nN, gid = wgid / nig, fm = gid * WGM, gsz = (nM - fm) < WGM ? (nM - fm) : WGM;
        u.pm = fm + ((wgid % nig) % gsz); u.pn = (wgid % nig) / gsz; u.aux = i & 1; return true;
    }
    __device__ __forceinline__ void a_ready(const Unit&) const {}
    __device__ __forceinline__ void done(const Unit&) const {}
};
__device__ __forceinline__ unsigned cvt_pk_bf16(float lo, float hi) { unsigned r; asm volatile("v_cvt_pk_bf16_f32 %0, %1, %2" : "=v"(r) : "v"(lo), "v"(hi)); return r; }
typedef float f32x2 __attribute__((ext_vector_type(2)));
template <class Epi, class Sched, bool STAMP = false>
__device__ __forceinline__ void gemm_phase(PG8_LAS unsigned char* lds, const Gemm g, const Sched& S, const Epi& E, unsigned long long* stamps) {
    unsigned m_ = ~0u; asm volatile("" : "+s"(m_)); int tid_ = S.wv * 64 + (int)__builtin_amdgcn_mbcnt_hi(m_, __builtin_amdgcn_mbcnt_lo(m_, 0u)); asm volatile("" : "+v"(tid_)); const int tid = tid_, wid = __builtin_amdgcn_readfirstlane(tid >> 6), lane = tid & 63, wr = wid >> 2, wc = wid & 3, fr = lane & 15, fq = lane >> 4;
    const int K = g.K, nt = K / BK;
    int ts_lo = 0, ts_hi = 0, nts = 0; const unsigned long long rt_entry = STAMP ? (unsigned long long)wall_clock64() : 0ull;
#define PG8_STAMP() do { if (STAMP && wid == 0 && nts < 64) { const unsigned long long _c = (unsigned long long)clock64(); \
        ts_lo = (lane == nts) ? (int)(unsigned)_c : ts_lo; ts_hi = (lane == nts) ? (int)(unsigned)(_c >> 32) : ts_hi; ++nts; } } while (0)
    PG8_STAMP();
    unsigned voffA[2], voffB[2];
#pragma unroll
    for (int i = 0; i < 2; ++i) { int R, C; stage_rc(tid * 16 + i * 8192, R, C); const int Rb = Epi::PERM ? ((R & ~31) + perm32(R & 31)) : R;
        voffA[i] = (unsigned)(R * K + C) * 2u; voffB[i] = (unsigned)(Rb * K + C) * 2u; }
    const size_t kstep = (size_t)(BK * 2);
    const size_t hstep = (size_t)HALF * K * 2;
    const size_t tstep = 2 * hstep;
    const unsigned ldsw = (unsigned)wid * 1024u;
    const int aoff = lds_byte(wr * 64 + fr, fq * 8), boff = lds_byte(wc * 32 + fr, fq * 8);
#define PG8_SA(b, h) (((b) * 2 + (h)) * HTB)
#define PG8_SB(b, h) ((4 + (b) * 2 + (h)) * HTB)
#define PG8_STAGE(bufoff, gbase, voff) do { _Pragma("unroll") for (int _i = 0; _i < 2; ++_i) \
        __builtin_amdgcn_global_load_lds((const unsigned*)((const char*)(gbase) + (voff)[_i]), (PG8_LAS unsigned*)(lds + (bufoff) + ldsw + _i * 8192), 16, 0, 0); } while (0)
#define PG8_LDA(dst, b, h) do { _Pragma("unroll") for (int m = 0; m < 4; ++m) _Pragma("unroll") for (int k = 0; k < 2; ++k) dst[m][k] = *(const PG8_LAS bf16x8*)(lds + PG8_SA(b, h) + aoff + m * 2048 + k * 1024); } while (0)
#define PG8_LDB(dst, b, h) do { _Pragma("unroll") for (int n = 0; n < 2; ++n) _Pragma("unroll") for (int k = 0; k < 2; ++k) dst[n][k] = *(const PG8_LAS bf16x8*)(lds + PG8_SB(b, h) + boff + n * 2048 + k * 1024); } while (0)
#define PG8_MMA(ai, bj, At, Bt) do { __builtin_amdgcn_s_setprio(1); _Pragma("unroll") for (int m = 0; m < 4; ++m) _Pragma("unroll") for (int n = 0; n < 2; ++n) _Pragma("unroll") for (int k = 0; k < 2; ++k) \
        acc[ai][bj][m][n] = __builtin_amdgcn_mfma_f32_16x16x32_bf16(Bt[n][k], At[m][k], acc[ai][bj][m][n], 0, 0, 0); __builtin_amdgcn_s_setprio(0); } while (0)
#define PG8_WAIT_V(n) asm volatile("s_waitcnt vmcnt(" #n ")" ::: "memory")
#define PG8_WAIT_L(n) asm volatile("s_waitcnt lgkmcnt(" #n ")" ::: "memory")
#define PG8_BAR __builtin_amdgcn_s_barrier()
#define PG8_SCHED __builtin_amdgcn_sched_barrier(0)
    Unit cur, nxt; int ui = 0;
    if (!S.next(0, cur)) return;
    f32x4 acc[2][2][4][2];
#pragma unroll
    for (int a = 0; a < 2; ++a)
#pragma unroll
        for (int b = 0; b < 2; ++b)
#pragma unroll
            for (int m = 0; m < 4; ++m)
#pragma unroll
                for (int n = 0; n < 2; ++n) acc[a][b][m][n] = (f32x4){0.f, 0.f, 0.f, 0.f};
    bf16x8 At[4][2], B0[2][2], B1[2][2];
    const char* cA = (const char*)g.A + (size_t)cur.pm * tstep; const char* cB = (const char*)g.Bt + (size_t)cur.pn * tstep;
    S.a_ready(cur);
    PG8_STAGE(PG8_SB(0, 0), cB, voffB); PG8_STAGE(PG8_SA(0, 0), cA, voffA); PG8_STAGE(PG8_SB(0, 1), cB + hstep, voffB); PG8_STAGE(PG8_SA(0, 1), cA + hstep, voffA);
    if (wr == 1) PG8_BAR;
    PG8_WAIT_V(4); PG8_BAR;
    PG8_STAGE(PG8_SB(1, 0), cB + kstep, voffB); PG8_STAGE(PG8_SA(1, 0), cA + kstep, voffA); PG8_STAGE(PG8_SB(1, 1), cB + hstep + kstep, voffB);
    PG8_WAIT_V(6); PG8_BAR;
    PG8_STAMP();
    for (;;) {
        const bool has_next = S.next(ui + 1, nxt);
        const char* nA = has_next ? (const char*)g.A + (size_t)nxt.pm * tstep : cA; const char* nB = has_next ? (const char*)g.Bt + (size_t)nxt.pn * tstep : cB;
        for (int t = 0; t < nt; t += 2) {
            const bool last = (t == nt - 2);
            const char* a1 = cA + (size_t)(t + 1) * kstep;
            const char* a2 = last ? nA : cA + (size_t)(t + 2) * kstep; const char* b2 = last ? nB : cB + (size_t)(t + 2) * kstep;
            const char* a3 = a2 + kstep; const char* b3 = b2 + kstep;
            if (last && has_next) S.a_ready(nxt);
            PG8_LDB(B0, 0, 0); PG8_SCHED; PG8_LDA(At, 0, 0); PG8_STAGE(PG8_SA(1, 1), a1 + hstep, voffA);
            PG8_WAIT_L(8); PG8_BAR; PG8_WAIT_L(0); PG8_MMA(0, 0, At, B0); PG8_BAR; PG8_SCHED;
            PG8_LDB(B1, 0, 1); PG8_STAGE(PG8_SB(0, 0), b2, voffB);
            PG8_BAR; PG8_WAIT_L(0); PG8_MMA(0, 1, At, B1); PG8_BAR;
            PG8_LDA(At, 0, 1); PG8_STAGE(PG8_SA(0, 0), a2, voffA);
            PG8_BAR; PG8_WAIT_L(0); PG8_MMA(1, 0, At, B0); PG8_BAR; PG8_SCHED;
            PG8_STAGE(PG8_SB(0, 1), b2 + hstep, voffB);
            PG8_WAIT_V(6); PG8_BAR; PG8_MMA(1, 1, At, B1); PG8_BAR;
            PG8_LDB(B0, 1, 0); PG8_SCHED; PG8_LDA(At, 1, 0); PG8_STAGE(PG8_SA(0, 1), a2 + hstep, voffA);
            PG8_WAIT_L(8); PG8_BAR; PG8_WAIT_L(0); PG8_MMA(0, 0, At, B0); PG8_BAR; PG8_SCHED;
            PG8_LDB(B1, 1, 1); PG8_STAGE(PG8_SB(1, 0), b3, voffB);
            PG8_BAR; PG8_WAIT_L(0); PG8_MMA(0, 1, At, B1); PG8_BAR;
            PG8_LDA(At, 1, 1); PG8_STAGE(PG8_SA(1, 0), a3, voffA);
            PG8_BAR; PG8_WAIT_L(0); PG8_MMA(1, 0, At, B0); PG8_BAR; PG8_SCHED;
            PG8_STAGE(PG8_SB(1, 1), b3 + hstep, voffB);
            PG8_WAIT_V(6); PG8_BAR; PG8_MMA(1, 1, At, B1); PG8_BAR;
        }
        PG8_STAMP();
        if constexpr (!Epi::AFTER_DRAIN) { E(acc, cur, wr, wc, fr, fq); S.done(cur); }
        PG8_STAMP();
        if (!has_next) break;
#pragma unroll
        for (int a = 0; a < 2; ++a)
#pragma unroll
            for (int b = 0; b < 2; ++b)
#pragma unroll
                for (int m = 0; m < 4; ++m)
#pragma unroll
                    for (int n = 0; n < 2; ++n) acc[a][b][m][n] = (f32x4){0.f, 0.f, 0.f, 0.f};
        cur = nxt; cA = nA; cB = nB; ++ui;
    }
    PG8_WAIT_V(0);
    if (wr == 0) PG8_BAR;
    PG8_BAR;
    if constexpr (Epi::AFTER_DRAIN) { E.fused(acc, cur, wr, wc, fr, fq, lds, wid, lane); S.done(cur); }
    PG8_STAMP();
    if (STAMP && wid == 0) { stamps[lane] = lane < nts ? (((unsigned long long)(unsigned)ts_hi << 32) | (unsigned)ts_lo) : 0ull;
        if (lane == 62) stamps[62] = rt_entry; if (lane == 63) stamps[63] = (unsigned long long)wall_clock64(); }
#undef PG8_STAMP
#undef PG8_SA
#undef PG8_SB
#undef PG8_STAGE
#undef PG8_LDA
#undef PG8_LDB
#undef PG8_MMA
#undef PG8_WAIT_V
#undef PG8_WAIT_L
#undef PG8_BAR
#undef PG8_SCHED
}
}
using pg8::bf16_t; using pg8::f32x4; using pg8::u32x4; using pg8::Unit;
typedef float f32x2_t __attribute__((ext_vector_type(2)));
typedef unsigned u32x2 __attribute__((ext_vector_type(2)));
typedef __bf16 bf16x2_t __attribute__((ext_vector_type(2)));
__device__ __forceinline__ unsigned pk2(float a, float b) { f32x2_t v = {a, b}; bf16x2_t r = __builtin_convertvector(v, bf16x2_t); return __builtin_bit_cast(unsigned, r); }
#define LAS PG8_LAS
constexpr int T_TOK = 32768, DM = 1024, SEQ = 8192;
constexpr float DN_ALPHA = 1.681792830507429f;
constexpr size_t MiB = 1ull << 20;
constexpr size_t WS_W_IN = 0, WS_W_KV = 10 * MiB, WS_W_O = 12 * MiB, WS_W1 = 15 * MiB, WS_W2 = 23 * MiB, WS_GLU = 31 * MiB, WS_MEMB = 33 * MiB, WS_KV = 35 * MiB, WS_BA = 37 * MiB,
                 WS_XB = 64 * MiB, WS_MIX = 128 * MiB, WS_R1 = 224 * MiB;
constexpr size_t WS_HALO = 39 * MiB, WS_CSUM = 49 * MiB, WS_STPA = 52 * MiB, WS_STPB = 56 * MiB, WS_BAR = 60 * MiB;
constexpr int LDS_BYTES = 163840;
constexpr size_t WS_ALT = 480 * MiB;
__device__ __forceinline__ size_t wofs(int layer, size_t even_off, size_t alt_off) { return (layer & 1) ? WS_ALT + alt_off : even_off; }
constexpr int NPH = 11;
constexpr int STAT_LDS = 131072;
constexpr int G2_WAVE_LDS = 17408, SC_BUF = 50176;

struct Params { const float* in[26]; float* out; unsigned char* ws; int ph_lo, ph_hi; };

__device__ __forceinline__ float bf2f(bf16_t h) { return __uint_as_float(((unsigned)h) << 16); }
__device__ __forceinline__ float bflo(unsigned w) { return __uint_as_float(w << 16); }
__device__ __forceinline__ float bfhi(unsigned w) { return __uint_as_float(w & 0xffff0000u); }
__device__ __forceinline__ bf16_t f2bf(float x) { return (bf16_t)(pg8::cvt_pk_bf16(x, 0.f) & 0xffffu); }
__device__ __forceinline__ float sigmoidf_(float x) { return 1.f / (1.f + __expf(-x)); }
__device__ __forceinline__ float wave_sum(float v) {
#pragma unroll
    for (int o = 32; o >= 1; o >>= 1) v += __shfl_xor(v, o);
    return v; }
__device__ __forceinline__ float wave_max(float v) {
#pragma unroll
    for (int o = 32; o >= 1; o >>= 1) v = fmaxf(v, __shfl_xor(v, o));
    return v; }
__device__ __forceinline__ void wave_sync() { __builtin_amdgcn_fence(__ATOMIC_RELEASE, "wavefront"); __builtin_amdgcn_wave_barrier(); __builtin_amdgcn_fence(__ATOMIC_ACQUIRE, "wavefront"); }

__device__ __forceinline__ int otid(int wv) { unsigned m = ~0u; asm volatile("" : "+s"(m)); int t = wv * 64 + (int)__builtin_amdgcn_mbcnt_hi(m, __builtin_amdgcn_mbcnt_lo(m, 0u)); asm volatile("" : "+v"(t)); return t; }
__device__ __forceinline__ void row_stats(const float* stp, size_t row, float& mu, float& rstd) {
    const f32x4* q = (const f32x4*)(stp + row * 32); float s = 0.f, ss = 0.f;
#pragma unroll
    for (int i = 0; i < 8; ++i) { const f32x4 v = q[i]; s += v[0] + v[2]; ss += v[1] + v[3]; }
    mu = s * (1.f / 1024.f); rstd = rsqrtf(fmaxf(ss * (1.f / 1024.f) - mu * mu, 0.f) + 1e-5f);
}
template <int MODE> struct EpiRoute {
    static constexpr bool PERM = true, AFTER_DRAIN = false;
    bf16_t* o0; bf16_t* o1; bf16_t* o2; float* ba; const bf16_t* zg; const float* bias; const float* stp = nullptr; const float* c1 = nullptr; const float* c2 = nullptr; LAS unsigned char* sl = nullptr;
    __device__ __forceinline__ void operator()(const f32x4 (&acc)[2][2][4][2], const Unit& u, int wr, int wc, int fr, int fq) const {
        bf16_t* zdst = (bf16_t*)zg;
        const int row0 = u.pm * 256 + wr * 64 + fr, colb = u.pn * 256 + wc * 32 + 8 * fq;
        f32x4 k1[2][2], k2[2][2];
        if (MODE <= 2 && stp) {
#pragma unroll
            for (int bj = 0; bj < 2; ++bj)
#pragma unroll
                for (int n = 0; n < 2; ++n) { k1[bj][n] = *(const f32x4*)(c1 + colb + bj * 128 + 4 * n); k2[bj][n] = *(const f32x4*)(c2 + colb + bj * 128 + 4 * n); } }
#pragma unroll
        for (int ai = 0; ai < 2; ++ai)
#pragma unroll
            for (int m = 0; m < 4; ++m) {
                const size_t row = (size_t)(row0 + ai * 128 + m * 16);
                float mu = 0.f, rs = 1.f; if (MODE <= 2 && stp) { const f32x2_t st = *(const LAS f32x2_t*)(sl + STAT_LDS + u.aux * 2048 + (int)(row & 255) * 8); mu = st[0]; rs = st[1]; }
#pragma unroll
                for (int bj = 0; bj < 2; ++bj) {
                    const int col = colb + bj * 128;
                    f32x4 v0 = acc[ai][bj][m][0], v1 = acc[ai][bj][m][1];
                    if (MODE <= 2 && stp) { v0 = (v0 - k1[bj][0] * mu) * rs + k2[bj][0]; v1 = (v1 - k1[bj][1] * mu) * rs + k2[bj][1]; }
                    bf16_t* dst;
                    if (MODE == 0) {
                        if (u.pn < 12) { dst = o0 + row * 3072 + col;
                            if (m == 3 && fr >= 13) { u32x4 hw; hw.x = pg8::cvt_pk_bf16(v0[0], v0[1]); hw.y = pg8::cvt_pk_bf16(v0[2], v0[3]); hw.z = pg8::cvt_pk_bf16(v1[0], v1[1]); hw.w = pg8::cvt_pk_bf16(v1[2], v1[3]);
                                *(u32x4*)(o1 + (((row >> 6) * 3 + (size_t)(fr - 13)) * 3072 + col)) = hw; } }
                        else if (u.pn < 16) dst = zdst + row * 1024 + (col - 3072);
                        else if (u.pn < 18) dst = o2 + row * 1536 + 1024 + (col - 4096);
                        else { if (col - 4608 < 16) { float* b = ba + row * 16 + (col - 4608); *(f32x4*)b = v0; *(f32x4*)(b + 4) = v1; } continue; }
                    } else if (MODE == 1) {
                        if (u.pn < 4) dst = o0 + ((size_t)((col >> 4) * 1024) + (row >> 5)) * 640 + (row & 31) * 16 + (col & 15); else dst = o2 + row * 1536 + col;
                    } else if (MODE == 2) {
#pragma unroll
                        for (int j = 0; j < 4; ++j) { float a = fmaxf(v0[j], 0.f), b = fmaxf(v1[j], 0.f); v0[j] = a * a; v1[j] = b * b; }
                        dst = o0 + row * 4096 + col;
                    } else if (MODE == 3) {
                        dst = o0 + row * 1024 + col;
                    } else {
                        const u32x4 z = *(const u32x4*)(zg + row * 1024 + col);
                        const f32x4 b0 = *(const f32x4*)(bias + col), b1 = *(const f32x4*)(bias + col + 4);
                        v0[0] = bflo(z.x) * sigmoidf_(v0[0] + b0[0]); v0[1] = bfhi(z.x) * sigmoidf_(v0[1] + b0[1]);
                        v0[2] = bflo(z.y) * sigmoidf_(v0[2] + b0[2]); v0[3] = bfhi(z.y) * sigmoidf_(v0[3] + b0[3]);
                        v1[0] = bflo(z.z) * sigmoidf_(v1[0] + b1[0]); v1[1] = bfhi(z.z) * sigmoidf_(v1[1] + b1[1]);
                        v1[2] = bflo(z.w) * sigmoidf_(v1[2] + b1[2]); v1[3] = bfhi(z.w) * sigmoidf_(v1[3] + b1[3]);
                        dst = o2 + row * 1536 + col;
                    }
                    u32x4 w; w.x = pg8::cvt_pk_bf16(v0[0], v0[1]); w.y = pg8::cvt_pk_bf16(v0[2], v0[3]); w.z = pg8::cvt_pk_bf16(v1[0], v1[1]); w.w = pg8::cvt_pk_bf16(v1[2], v1[3]);
                    *(u32x4*)dst = w;
                }
            }
    }
};
struct EpiRes {
    static constexpr bool PERM = false, AFTER_DRAIN = false;
    const float* res; const float* g; const float* b; bf16_t* yb; float* stp_out; LAS unsigned char* sl;
    __device__ __forceinline__ void operator()(const f32x4 (&acc)[2][2][4][2], const Unit& u, int wr, int wc, int fr, int fq) const {
        const int row0 = u.pm * 256 + wr * 64 + fr, col0 = u.pn * 256 + wc * 32 + 4 * fq;
        f32x4 gg[2][2], bb[2][2];
        if (!res) {
#pragma unroll
            for (int bj = 0; bj < 2; ++bj)
#pragma unroll
                for (int n = 0; n < 2; ++n) { gg[bj][n] = *(const f32x4*)(g + col0 + bj * 128 + n * 16); bb[bj][n] = *(const f32x4*)(b + col0 + bj * 128 + n * 16); } }
#pragma unroll
        for (int ai = 0; ai < 2; ++ai)
#pragma unroll
            for (int m = 0; m < 4; ++m) {
                const size_t row = (size_t)(row0 + ai * 128 + m * 16), off = row * 1024 + col0;
                float mu = 0.f, rs = 1.f; if (!res) { const f32x2_t st = *(const LAS f32x2_t*)(sl + STAT_LDS + u.aux * 2048 + (int)(row & 255) * 8); mu = st[0]; rs = st[1]; }
                float s = 0.f, ss = 0.f;
#pragma unroll
                for (int bj = 0; bj < 2; ++bj)
#pragma unroll
                    for (int n = 0; n < 2; ++n) {
                        f32x4 r;
                        if (res) r = *(const f32x4*)(res + off + bj * 128 + n * 16);
                        else { const u32x2 yw = *(const u32x2*)(yb + off + bj * 128 + n * 16); const f32x4 yv = {bflo(yw.x), bfhi(yw.x), bflo(yw.y), bfhi(yw.y)}; r = (yv - mu) * rs * gg[bj][n] + bb[bj][n]; }
                        const f32x4 y = r * DN_ALPHA + acc[ai][bj][m][n];
                        u32x2 w; w.x = pk2(y[0], y[1]); w.y = pk2(y[2], y[3]); *(u32x2*)(yb + off + bj * 128 + n * 16) = w;
                        s += y[0] + y[1] + y[2] + y[3]; ss += y[0] * y[0] + y[1] * y[1] + y[2] * y[2] + y[3] * y[3];
                    }
                s += __shfl_xor(s, 16); s += __shfl_xor(s, 32); ss += __shfl_xor(ss, 16); ss += __shfl_xor(ss, 32);
                if (fq == 0) { f32x2_t o; o[0] = s; o[1] = ss; *(f32x2_t*)(stp_out + (row * 16 + u.pn * 4 + wc) * 2) = o; }
            }
    }
};
struct StatOrder : pg8::StaticOrder {
    const float* stp; LAS unsigned char* sl;
    __device__ __forceinline__ void a_ready(const Unit& u) const {
        if (!stp) return;
        const int t = otid(wv), row = t >> 1, hf = t & 1; const f32x4* q = (const f32x4*)(stp + ((size_t)u.pm * 256 + row) * 32 + hf * 16); float s = 0.f, ss = 0.f;
#pragma unroll
        for (int i = 0; i < 4; ++i) { const f32x4 v = q[i]; s += v[0] + v[2]; ss += v[1] + v[3]; }
        s += __shfl_xor(s, 1); ss += __shfl_xor(ss, 1);
        const float mu = s * (1.f / 1024.f), rstd = rsqrtf(fmaxf(ss * (1.f / 1024.f) - mu * mu, 0.f) + 1e-5f);
        if (hf == 0) { f32x2_t o; o[0] = mu; o[1] = rstd; *(LAS f32x2_t*)(sl + STAT_LDS + u.aux * 2048 + row * 8) = o; }
    }
};
template <class Epi> __device__ __forceinline__ void run_gemm_st(int wv, LAS unsigned char* lds, const bf16_t* A, const bf16_t* Bt, int M, int N, int K, const Epi& E, const float* stp) {
    pg8::Gemm g; g.A = A; g.Bt = Bt; g.M = M; g.N = N; g.K = K;
    StatOrder S; S.init(M, N, (int)gridDim.x, (int)blockIdx.x); S.wv = wv; S.stp = stp; S.sl = lds;
    pg8::gemm_phase<Epi, StatOrder, false>(lds, g, S, E, nullptr);
}
template <class Epi> __device__ __forceinline__ void run_gemm(int wv, LAS unsigned char* lds, const bf16_t* A, const bf16_t* Bt, int M, int N, int K, const Epi& E) {
    pg8::Gemm g; g.A = A; g.Bt = Bt; g.M = M; g.N = N; g.K = K;
    pg8::StaticOrder S; S.init(M, N, (int)gridDim.x, (int)blockIdx.x); S.wv = wv;
    pg8::gemm_phase<Epi, pg8::StaticOrder, false>(lds, g, S, E, nullptr);
}

__device__ __forceinline__ void transpose_cvt(int wv, const float* src, int K, int N, bf16_t* dst, int Npad, int mode, float* tile, int blk0 = 0, int nblk = 0) {
    const int ntn = Npad / 64, ntk = K / 64, tid = otid(wv); if (nblk == 0) nblk = (int)gridDim.x; if ((int)blockIdx.x < blk0) return;
    for (int t = (int)blockIdx.x - blk0; t < ntn * ntk; t += nblk) {
        const int tn = t % ntn, tk = t / ntn, n0 = tn * 64, k0 = tk * 64;
        __syncthreads();
#pragma unroll
        for (int i = 0; i < 2; ++i) { const int e = tid + 512 * i, kk = e >> 4, n = n0 + (e & 15) * 4; int sc = n;
            if (mode == 1) sc = n < 4096 ? n : (n < 4608 ? n + 16 : (n < 4624 ? n - 512 : -1));
            else if (n >= N) sc = -1;
            f32x4 v = {0.f, 0.f, 0.f, 0.f}; if (sc >= 0) v = *(const f32x4*)(src + (size_t)(k0 + kk) * N + sc);
            *(f32x4*)(tile + kk * 68 + (e & 15) * 4) = v; }
        __syncthreads();
        { const int nn = tid >> 3, kc = (tid & 7) * 8; float v[8];
#pragma unroll
          for (int e = 0; e < 8; ++e) v[e] = tile[(kc + e) * 68 + nn];
          u32x4 w; w.x = pg8::cvt_pk_bf16(v[0], v[1]); w.y = pg8::cvt_pk_bf16(v[2], v[3]); w.z = pg8::cvt_pk_bf16(v[4], v[5]); w.w = pg8::cvt_pk_bf16(v[6], v[7]);
          *(u32x4*)(dst + (size_t)(n0 + nn) * K + k0 + kc) = w; }
    }
}
__device__ __forceinline__ void transpose_cvt_fold(int wv, const float* src, int N, bf16_t* dst, int Npad, int mode, float* tile, const float* gv, const float* bv, float* c1p, float* c2p, int blk0 = 0, int nblk = 0) {
    const int ntn = Npad / 64, tid = otid(wv); float* tileB = tile + 64 * 68; if (nblk == 0) nblk = (int)gridDim.x; if ((int)blockIdx.x < blk0) return;
    for (int item = (int)blockIdx.x - blk0; item < ntn * 4; item += nblk) {
        const int tn = item % ntn, kq = item / ntn, n0 = tn * 64; float a1 = 0.f, a2 = 0.f;
        for (int tk = kq * 4; tk < kq * 4 + 4; ++tk) { const int k0 = tk * 64;
            __syncthreads();
#pragma unroll
            for (int i = 0; i < 2; ++i) { const int e = tid + 512 * i, kk = e >> 4, n = n0 + (e & 15) * 4; int sc = n;
                if (mode == 1) sc = n < 4096 ? n : (n < 4608 ? n + 16 : (n < 4624 ? n - 512 : -1));
                else if (n >= N) sc = -1;
                f32x4 v = {0.f, 0.f, 0.f, 0.f}; if (sc >= 0) v = *(const f32x4*)(src + (size_t)(k0 + kk) * N + sc);
                *(f32x4*)(tile + kk * 68 + (e & 15) * 4) = v * gv[k0 + kk]; *(f32x4*)(tileB + kk * 68 + (e & 15) * 4) = v * bv[k0 + kk]; }
            __syncthreads();
            { const int nn = tid >> 3, kc = (tid & 7) * 8; float v[8];
#pragma unroll
              for (int e = 0; e < 8; ++e) { v[e] = tile[(kc + e) * 68 + nn]; a2 += tileB[(kc + e) * 68 + nn]; }
              u32x4 w; w.x = pk2(v[0], v[1]); w.y = pk2(v[2], v[3]); w.z = pk2(v[4], v[5]); w.w = pk2(v[6], v[7]);
              a1 += bflo(w.x) + bfhi(w.x) + bflo(w.y) + bfhi(w.y) + bflo(w.z) + bfhi(w.z) + bflo(w.w) + bfhi(w.w);
              *(u32x4*)(dst + (size_t)(n0 + nn) * 1024 + k0 + kc) = w; }
        }
        a1 += __shfl_xor(a1, 1); a1 += __shfl_xor(a1, 2); a1 += __shfl_xor(a1, 4); a2 += __shfl_xor(a2, 1); a2 += __shfl_xor(a2, 2); a2 += __shfl_xor(a2, 4);
        if ((tid & 7) == 0) { c1p[kq * Npad + n0 + (tid >> 3)] = a1; c2p[kq * Npad + n0 + (tid >> 3)] = a2; }
    }
}
__device__ __forceinline__ void cvt_rows(int wv, const float* src, bf16_t* dst, size_t n) {
    const size_t stride = (size_t)gridDim.x * 512 * 4;
    size_t i = ((size_t)blockIdx.x * 512 + otid(wv)) * 4;
    for (; i + 3 * stride < n; i += 4 * stride) { f32x4 v[4];
#pragma unroll
        for (int k = 0; k < 4; ++k) v[k] = *(const f32x4*)(src + i + k * stride);
#pragma unroll
        for (int k = 0; k < 4; ++k) { uint2 w; w.x = pg8::cvt_pk_bf16(v[k][0], v[k][1]); w.y = pg8::cvt_pk_bf16(v[k][2], v[k][3]); *(uint2*)(dst + i + k * stride) = w; } }
    for (; i < n; i += stride) { const f32x4 v = *(const f32x4*)(src + i); uint2 w; w.x = pg8::cvt_pk_bf16(v[0], v[1]); w.y = pg8::cvt_pk_bf16(v[2], v[3]); *(uint2*)(dst + i) = w; }
}
__device__ __forceinline__ void csum_finalize(int wv, const float* c1p, const float* c2p, float* c1, float* c2, int NP) {
    for (int n = blockIdx.x * 512 + otid(wv); n < NP; n += gridDim.x * 512) { c1[n] = c1p[n] + c1p[NP + n] + c1p[2 * NP + n] + c1p[3 * NP + n]; c2[n] = c2p[n] + c2p[NP + n] + c2p[2 * NP + n] + c2p[3 * NP + n]; }
}
__device__ __forceinline__ void ph_convert_in(int wv, const Params& p, int layer, float* tile, int blk0 = 0, int nblk = 0) {
    const int j = layer >> 1; unsigned char* ws = p.ws; float* cs = (float*)(ws + WS_CSUM);
    const float* g2 = p.in[6] + (layer > 0 ? layer - 1 : 0) * 1024; const float* b2 = p.in[7] + (layer > 0 ? layer - 1 : 0) * 1024;
    if ((layer & 1) == 0) { if (layer == 0) transpose_cvt(wv, p.in[10] + (size_t)j * 1024 * 4624, 1024, 4624, (bf16_t*)(ws + WS_W_IN), 4864, 1, tile, blk0, nblk);
                            else transpose_cvt_fold(wv, p.in[10] + (size_t)j * 1024 * 4624, 4624, (bf16_t*)(ws + WS_W_IN), 4864, 1, tile, g2, b2, cs, cs + 19456, blk0, nblk); }
    else { transpose_cvt_fold(wv, p.in[15] + (size_t)j * 1024 * 1536, 1536, (bf16_t*)(ws + WS_W_IN), 1536, 0, tile, g2, b2, cs, cs + 19456, blk0, nblk);
           transpose_cvt(wv, p.in[24] + (size_t)j * 1024 * 1024, 1024, 1024, (bf16_t*)(ws + WS_GLU), 1024, 0, tile, blk0, nblk); }
    transpose_cvt(wv, p.in[2] + (size_t)layer * 1024 * 1024, 1024, 1024, (bf16_t*)(ws + WS_W_KV), 1024, 0, tile, blk0, nblk);
}
__device__ __forceinline__ void ph_convert_wo(int wv, const Params& p, int layer, float* tile, int blk0 = 0, int nblk = 0) { transpose_cvt(wv, p.in[3] + (size_t)layer * 1536 * 1024, 1536, 1024, (bf16_t*)(p.ws + wofs(layer, WS_W_O, 0)), 1024, 0, tile, blk0, nblk); }
__device__ __forceinline__ void ph_convert_w1(int wv, const Params& p, int layer, float* tile, int blk0 = 0, int nblk = 0) { float* cs = (float*)(p.ws + WS_CSUM);
    transpose_cvt_fold(wv, p.in[8] + (size_t)layer * 1024 * 4096, 4096, (bf16_t*)(p.ws + wofs(layer, WS_W1, 3 * MiB)), 4096, 0, tile, p.in[4] + layer * 1024, p.in[5] + layer * 1024, cs + ((layer & 1) ? 89600 : 38912), cs + ((layer & 1) ? 105984 : 55296), blk0, nblk); }
__device__ __forceinline__ void ph_convert_w2(int wv, const Params& p, int layer, float* tile, int blk0 = 0, int nblk = 0) { transpose_cvt(wv, p.in[9] + (size_t)layer * 4096 * 1024, 4096, 1024, (bf16_t*)(p.ws + wofs(layer, WS_W2, 11 * MiB)), 1024, 0, tile, blk0, nblk); }

__device__ __forceinline__ void ph_ln_final(int wv, const bf16_t* yb, float* out, const float* g, const float* b) {
    const int tid0 = otid(wv), wave = tid0 >> 6, lane = tid0 & 63;
    for (int row0 = blockIdx.x * 8 + wave; row0 < T_TOK; row0 += gridDim.x * 16) {
        u32x2 w[2][4]; int rows[2];
#pragma unroll
        for (int k = 0; k < 2; ++k) { rows[k] = row0 + k * (int)gridDim.x * 8; const int rr = rows[k] < T_TOK ? rows[k] : row0;
#pragma unroll
            for (int i = 0; i < 4; ++i) w[k][i] = *(const u32x2*)(yb + (size_t)rr * 1024 + i * 256 + lane * 4); }
#pragma unroll
        for (int k = 0; k < 2; ++k) { if (rows[k] >= T_TOK) continue;
            f32x4 v[4]; float s = 0.f;
#pragma unroll
            for (int i = 0; i < 4; ++i) { v[i] = (f32x4){bflo(w[k][i].x), bfhi(w[k][i].x), bflo(w[k][i].y), bfhi(w[k][i].y)}; s += v[i][0] + v[i][1] + v[i][2] + v[i][3]; }
            const float mu = wave_sum(s) * (1.f / 1024.f); float q = 0.f;
#pragma unroll
            for (int i = 0; i < 4; ++i)
#pragma unroll
                for (int e = 0; e < 4; ++e) { const float d = v[i][e] - mu; q += d * d; }
            const float rstd = rsqrtf(wave_sum(q) * (1.f / 1024.f) + 1e-5f);
#pragma unroll
            for (int i = 0; i < 4; ++i) { const int c = i * 256 + lane * 4; const f32x4 gg = *(const f32x4*)(g + c), bb = *(const f32x4*)(b + c); f32x4 o;
#pragma unroll
                for (int e = 0; e < 4; ++e) o[e] = (v[i][e] - mu) * rstd * gg[e] + bb[e];
                *(f32x4*)(out + (size_t)rows[k] * 1024 + c) = o; } }
    }
}

__device__ __forceinline__ void ph_gdn_gnorm(int wv, const Params& p, int j, bf16_t* dummy = nullptr) {
    const bf16_t* z = (const bf16_t*)(p.ws + WS_R1 + 192 * MiB); bf16_t* mix = (bf16_t*)(p.ws + WS_MIX); (void)dummy;
    const int tid0 = otid(wv), wave = tid0 >> 6, lane = tid0 & 63, sub = lane >> 4, l16 = lane & 15;
    const f32x4 g0 = *(const f32x4*)(p.in[14] + j * 128 + l16 * 8), g1 = *(const f32x4*)(p.in[14] + j * 128 + l16 * 8 + 4);
    for (int i4 = blockIdx.x * 8 + wave; i4 < T_TOK * 2; i4 += gridDim.x * 16) {
        bf16_t* op[2]; u32x4 ow[2], zw[2];
#pragma unroll
        for (int k = 0; k < 2; ++k) { if (i4 + k * (int)gridDim.x * 8 >= T_TOK * 2) { op[k] = nullptr; continue; } const int item = (i4 + k * (int)gridDim.x * 8) * 4 + sub; const size_t tok = (size_t)(item >> 3); const int h = item & 7;
            op[k] = mix + tok * 1536 + h * 128 + l16 * 8; ow[k] = *(const u32x4*)op[k]; zw[k] = *(const u32x4*)(z + tok * 1024 + h * 128 + l16 * 8); }
#pragma unroll
        for (int k = 0; k < 2; ++k) { if (!op[k]) continue;
            const float o[8] = {bflo(ow[k].x), bfhi(ow[k].x), bflo(ow[k].y), bfhi(ow[k].y), bflo(ow[k].z), bfhi(ow[k].z), bflo(ow[k].w), bfhi(ow[k].w)}, zz[8] = {bflo(zw[k].x), bfhi(zw[k].x), bflo(zw[k].y), bfhi(zw[k].y), bflo(zw[k].z), bfhi(zw[k].z), bflo(zw[k].w), bfhi(zw[k].w)};
            float ss = 0.f;
#pragma unroll
            for (int e = 0; e < 8; ++e) ss += o[e] * o[e];
            ss += __shfl_xor(ss, 1); ss += __shfl_xor(ss, 2); ss += __shfl_xor(ss, 4); ss += __shfl_xor(ss, 8);
            const float r = rsqrtf(ss * (1.f / 128.f) + 1e-6f);
            float y[8];
#pragma unroll
            for (int e = 0; e < 8; ++e) y[e] = o[e] * r * (e < 4 ? g0[e & 3] : g1[e & 3]) * zz[e] * sigmoidf_(zz[e]);
            u32x4 w; w.x = pk2(y[0], y[1]); w.y = pk2(y[2], y[3]); w.z = pk2(y[4], y[5]); w.w = pk2(y[6], y[7]);
            *(u32x4*)op[k] = w; }
    }
}

typedef short bf16x8 __attribute__((ext_vector_type(8)));
typedef short s16x4 __attribute__((ext_vector_type(4)));
__device__ __forceinline__ bf16x8 pack8(const f32x4& lo, const f32x4& hi) { u32x4 w; w.x = pk2(lo[0], lo[1]); w.y = pk2(lo[2], lo[3]); w.z = pk2(hi[0], hi[1]); w.w = pk2(hi[2], hi[3]); return __builtin_bit_cast(bf16x8, w); }
#define MFMA16(a, b, c) __builtin_amdgcn_mfma_f32_16x16x32_bf16((a), (b), (c), 0, 0, 0)

template <int K> __device__ __forceinline__ float dpp_shr(float x) { return __int_as_float(__builtin_amdgcn_update_dpp(0, __float_as_int(x), 0x110 + K, 0xf, 0xf, true)); }
template <int K> __device__ __forceinline__ float dpp_shl(float x) { return __int_as_float(__builtin_amdgcn_update_dpp(0, __float_as_int(x), 0x100 + K, 0xf, 0xf, true)); }
__device__ __forceinline__ void unpack8(const u32x4& w, float (&f)[8]) { f[0] = bflo(w.x); f[1] = bfhi(w.x); f[2] = bflo(w.y); f[3] = bfhi(w.y); f[4] = bflo(w.z); f[5] = bfhi(w.z); f[6] = bflo(w.w); f[7] = bfhi(w.w); }

__device__ __forceinline__ void ph_gdn_prep(int wv, const Params& p, int j, unsigned char* smem, const bool dry = false) {
    for (int pair = blockIdx.x; pair < 512; pair += gridDim.x) {
        const int tid = otid(wv), wave = tid >> 6, lane = tid & 63, r = lane & 15, g = lane >> 4, h = wave;
        bf16_t* pq = (bf16_t*)(p.ws + WS_R1); float* BA = (float*)(p.ws + WS_BA); const bf16_t* HALO = (const bf16_t*)(p.ws + WS_HALO);
        LAS unsigned char* lds = (LAS unsigned char*)smem;
        float* Al = (float*)(smem + wave * G2_WAVE_LDS); float* sgc = Al + 4096; float* sbeta = sgc + 64;
        int jo = j; asm volatile("" : "+s"(jo));
        const float a_coef = -__expf(p.in[12][jo * 8 + h]), dtb = p.in[13][jo * 8 + h];
        const float* cwb = p.in[11] + (size_t)jo * 4 * 3072;
        const int n = pair & 127; const size_t t0 = (size_t)pair * 64;
        const bf16_t* halo = n > 0 ? HALO + (size_t)(pair - 1) * 3 * 3072 : nullptr;
        unsigned char* blob = (unsigned char*)p.out + ((size_t)pair * 8 + h) * 16384;
        {
            const size_t tok = t0 + lane; const float bl = BA[tok * 16 + h], al = BA[tok * 16 + 8 + h];
            const float beta = sigmoidf_(bl); const float spi = al + dtb; const float sp = fmaxf(spi, 0.f) + log1pf(__expf(-fabsf(spi)));
            float gc = a_coef * sp;
            { int l2 = lane; asm volatile("" : "+v"(l2));
#pragma unroll
              for (int o = 1; o < 64; o <<= 1) { const float t = __int_as_float(__builtin_amdgcn_ds_bpermute((l2 - o) << 2, __float_as_int(gc))); if (l2 >= o) gc += t; } }
            wave_sync();
            sgc[lane] = gc; sbeta[lane] = beta; BA[tok * 16 + h] = beta; BA[tok * 16 + 8 + h] = gc;
            wave_sync();
        }
        { LAS float* wl = (LAS float*)(lds + wave * G2_WAVE_LDS);
#pragma unroll
          for (int e = 0; e < 24; ++e) { const int idx = e * 64 + lane, st = idx >> 7, c = idx & 127; wl[idx] = cwb[(st & 3) * 3072 + (st >> 2) * 1024 + h * 128 + c]; }
          wave_sync();
#pragma unroll 1
          for (int si = 0; si < 3; ++si) { const int sec = si == 0 ? 2 : si - 1; const int colbase = sec * 1024 + h * 128;
            int lane_ = lane; asm volatile("" : "+v"(lane_)); const int r = lane_ & 15, g = lane_ >> 4;
            u32x4 cur[4], prv[4], nxt[4];
#pragma unroll
            for (int ks = 0; ks < 4; ++ks) { cur[ks] = *(const u32x4*)(pq + (t0 + 48 + r) * 3072 + colbase + 32 * ks + 8 * g); prv[ks] = *(const u32x4*)(pq + (t0 + 32 + r) * 3072 + colbase + 32 * ks + 8 * g); nxt[ks] = (u32x4){0u, 0u, 0u, 0u}; }
#pragma unroll 1
            for (int mi = 0; mi < 4; ++mi) { const int mb = 3 - mi; float cv[4][8];
                if (mb >= 2) {
#pragma unroll
                    for (int ks = 0; ks < 4; ++ks) nxt[ks] = *(const u32x4*)(pq + (t0 + 16 * (mb - 2) + r) * 3072 + colbase + 32 * ks + 8 * g); }
                else if (mb == 1) { const bf16_t* hp = halo ? halo + (size_t)(r >= 13 ? r - 13 : 0) * 3072 : pq + t0 * 3072;
#pragma unroll
                    for (int ks = 0; ks < 4; ++ks) { u32x4 w = *(const u32x4*)(hp + colbase + 32 * ks + 8 * g); if (!halo) w = (u32x4){0u, 0u, 0u, 0u}; nxt[ks] = w; } }
#pragma unroll
                for (int ks = 0; ks < 4; ++ks) { float xf[8], pf[8], acc[8]; unpack8(cur[ks], xf); unpack8(prv[ks], pf);
                    const LAS float* wk = wl + sec * 512 + 32 * ks + 8 * g;
                    { const f32x4 w0 = *(const LAS f32x4*)(wk + 384), w1 = *(const LAS f32x4*)(wk + 388);
#pragma unroll
                      for (int e = 0; e < 8; ++e) acc[e] = (e < 4 ? w0[e & 3] : w1[e & 3]) * xf[e]; }
                    { const f32x4 w0 = *(const LAS f32x4*)(wk + 256), w1 = *(const LAS f32x4*)(wk + 260);
#pragma unroll
                      for (int e = 0; e < 8; ++e) acc[e] += (e < 4 ? w0[e & 3] : w1[e & 3]) * (dpp_shr<1>(xf[e]) + dpp_shl<15>(pf[e])); }
                    { const f32x4 w0 = *(const LAS f32x4*)(wk + 128), w1 = *(const LAS f32x4*)(wk + 132);
#pragma unroll
                      for (int e = 0; e < 8; ++e) acc[e] += (e < 4 ? w0[e & 3] : w1[e & 3]) * (dpp_shr<2>(xf[e]) + dpp_shl<14>(pf[e])); }
                    { const f32x4 w0 = *(const LAS f32x4*)(wk), w1 = *(const LAS f32x4*)(wk + 4);
#pragma unroll
                      for (int e = 0; e < 8; ++e) acc[e] += (e < 4 ? w0[e & 3] : w1[e & 3]) * (dpp_shr<3>(xf[e]) + dpp_shl<13>(pf[e])); }
#pragma unroll
                    for (int e = 0; e < 8; ++e) cv[ks][e] = acc[e] * sigmoidf_(acc[e]); }
                float rn = 1.f;
                if (sec < 2) { float ss = 0.f;
#pragma unroll
                    for (int ks = 0; ks < 4; ++ks)
#pragma unroll
                        for (int e = 0; e < 8; ++e) ss += cv[ks][e] * cv[ks][e];
                    ss += __shfl_xor(ss, 16); ss += __shfl_xor(ss, 32);
                    rn = rsqrtf(ss + 1e-6f) * (sec == 0 ? 0.08838834764831845f : 1.f); }
#pragma unroll
                for (int ks = 0; ks < 4; ++ks) { u32x4 w; w.x = pk2(cv[ks][0] * rn, cv[ks][1] * rn); w.y = pk2(cv[ks][2] * rn, cv[ks][3] * rn); w.z = pk2(cv[ks][4] * rn, cv[ks][5] * rn); w.w = pk2(cv[ks][6] * rn, cv[ks][7] * rn);
                    *(u32x4*)(pq + (t0 + 16 * mb + r) * 3072 + colbase + 32 * ks + 8 * g) = w; }
#pragma unroll
                for (int ks = 0; ks < 4; ++ks) { cur[ks] = prv[ks]; prv[ks] = nxt[ks]; }
            }
          }
        }
        wave_sync();
        bf16x8 kf[4][4];
#pragma unroll
        for (int mb = 0; mb < 4; ++mb)
#pragma unroll
            for (int ks = 0; ks < 4; ++ks) kf[mb][ks] = *(const bf16x8*)(pq + (t0 + 16 * mb + r) * 3072 + 1024 + h * 128 + 32 * ks + 8 * g);
        f32x4 gcr[4], br[4]; float gcc[4];
#pragma unroll
        for (int mb = 0; mb < 4; ++mb) { gcr[mb] = *(const f32x4*)(sgc + 16 * mb + 4 * g); br[mb] = *(const f32x4*)(sbeta + 16 * mb + 4 * g); gcc[mb] = sgc[16 * mb + r]; }
#pragma unroll
        for (int mb = 0; mb < 4; ++mb)
#pragma unroll
            for (int nb = 0; nb <= mb; ++nb) {
                f32x4 acc = {0.f, 0.f, 0.f, 0.f};
#pragma unroll
                for (int ks = 0; ks < 4; ++ks) acc = MFMA16(kf[mb][ks], kf[nb][ks], acc);
#pragma unroll
                for (int jj = 0; jj < 4; ++jj) { const int i = 16 * mb + 4 * g + jj, jc = 16 * nb + r;
                    Al[i * 64 + jc] = (jc < i) ? br[mb][jj] * acc[jj] * __expf(gcr[mb][jj] - gcc[nb]) : 0.f; }
            }
#pragma unroll
        for (int ib = 0; ib < 4; ++ib) {
            bf16x8 qfi[4];
#pragma unroll
            for (int ks = 0; ks < 4; ++ks) qfi[ks] = *(const bf16x8*)(pq + (t0 + 16 * ib + r) * 3072 + h * 128 + 32 * ks + 8 * g);
#pragma unroll
            for (int ks2 = 0; ks2 < 2; ++ks2) {
                f32x4 t2[2];
#pragma unroll
                for (int hh = 0; hh < 2; ++hh) { const int jb = 2 * ks2 + hh; f32x4 acc = {0.f, 0.f, 0.f, 0.f};
                    if (jb <= ib) {
#pragma unroll
                        for (int ks = 0; ks < 4; ++ks) acc = MFMA16(kf[jb][ks], qfi[ks], acc);
#pragma unroll
                        for (int jj = 0; jj < 4; ++jj) { const int jt = 16 * jb + 4 * g + jj, it = 16 * ib + r;
                            acc[jj] = (jt <= it) ? acc[jj] * __expf(gcc[ib] - gcr[jb][jj]) : 0.f; }
                    }
                    t2[hh] = acc; }
                *(bf16x8*)(blob + 8192 + ((ib * 2 + ks2) * 64 + lane) * 16) = pack8(t2[0], t2[1]);
            }
        }
        wave_sync();
        float Tr[64];
#pragma unroll
        for (int i = 0; i < 64; ++i) {
            float acc = 0.f;
#pragma unroll
            for (int k4 = 0; k4 < (i + 3) / 4; ++k4) { const f32x4 a = *(const f32x4*)(Al + i * 64 + k4 * 4);
#pragma unroll
                for (int e = 0; e < 4; ++e) if (k4 * 4 + e < i) acc += a[e] * Tr[k4 * 4 + e]; }
            Tr[i] = (lane == i) ? 1.f : -acc;
        }
        wave_sync();
        bf16_t* Tb = (bf16_t*)Al;
#pragma unroll
        for (int i = 0; i < 64; ++i) Tb[i * 64 + lane] = (bf16_t)(pk2(Tr[i], 0.f) & 0xffffu);
        wave_sync();
#pragma unroll
        for (int mb = 0; mb < 4; ++mb)
#pragma unroll
            for (int ks2 = 0; ks2 < 2; ++ks2) { const bf16_t* rowp = Tb + (16 * mb + r) * 64 + 32 * ks2 + 4 * g;
                const uint2 lo = *(const uint2*)rowp, hi = *(const uint2*)(rowp + 16); u32x4 w; w.x = lo.x; w.y = lo.y; w.z = hi.x; w.w = hi.y;
                *(u32x4*)(blob + ((mb * 2 + ks2) * 64 + lane) * 16) = w; }
        wave_sync();
    }
}

constexpr int SC_BUF2 = 54272;
__device__ __forceinline__ void ph_gdn_scan(int wv, const Params& p, unsigned char* smem) {
    if (blockIdx.x >= 64) return;
    const int tid = otid(wv), wave = __builtin_amdgcn_readfirstlane(tid >> 6), lane = tid & 63, r = lane & 15, g = lane >> 4;
    const int bh = blockIdx.x >> 1, half = blockIdx.x & 1, b = bh >> 3, h = bh & 7, s = half * 4 + (wave & 3);
    const bf16_t* pq = (const bf16_t*)(p.ws + WS_R1); const float* BA = (const float*)(p.ws + WS_BA); bf16_t* mix = (bf16_t*)(p.ws + WS_MIX);
    const unsigned char* blob0 = (const unsigned char*)p.out + ((size_t)(b * 128) * 8 + h) * 16384;
    LAS unsigned char* lds = (LAS unsigned char*)smem;
    const bool compute = wave < 4;
    const int fsw = ((r & 3) << 2) | (r >> 2);
    const int q4 = r >> 2, p4 = r & 3, ftr = (q4 << 2) | g;
    f32x4 S[8];
#pragma unroll
    for (int i = 0; i < 8; ++i) S[i] = (f32x4){0.f, 0.f, 0.f, 0.f};
#define GDN_ISSUE(nn, bf) do { const size_t t0_ = (size_t)b * SEQ + 64 * (nn); int l_ = lane; asm volatile("" : "+v"(l_)); const int r_ = l_ & 15, g_ = l_ >> 4;     \
        if (wave == 4) { const size_t tok = t0_ + l_; const float beta = BA[tok * 16 + h], gc = BA[tok * 16 + 8 + h], gl = __shfl(gc, 63); LAS float* sc = (LAS float*)(lds + (bf) * SC_BUF2 + 53248); \
            sc[l_] = beta; sc[64 + l_] = __expf(gc); sc[128 + l_] = __expf(gl - gc); if (l_ == 0) sc[192] = __expf(gl); } \
        _Pragma("unroll") for (int ii = 0; ii < 13; ++ii) { const int idx = (wave - 4) * 13 + ii; \
            if (idx < 32) { const int sec = idx < 16 ? 1 : 0, i4 = idx & 15, row = 4 * i4 + g_, ch = r_ ^ (((row & 3) << 2) | ((row >> 2) & 3)); \
                __builtin_amdgcn_global_load_lds((const unsigned*)(pq + (t0_ + row) * 3072 + sec * 1024 + h * 128 + ch * 8), (LAS unsigned*)(lds + (bf) * SC_BUF2 + (sec == 1 ? 0 : 16384) + i4 * 1024), 16, 0, 0); } \
            else if (idx < 44) { const int sl = (idx - 32) % 6, isA = (idx - 32) / 6, fi = sl == 0 ? 0 : (sl == 1 ? 2 : sl + 2); \
                __builtin_amdgcn_global_load_lds((const unsigned*)(blob0 + (size_t)(nn) * 8 * 16384 + isA * 8192 + fi * 1024 + l_ * 16), (LAS unsigned*)(lds + (bf) * SC_BUF2 + 32768 + isA * 6144 + sl * 1024), 16, 0, 0); } \
            else { const int i4 = idx - 44, row = 8 * i4 + (l_ >> 3); \
                __builtin_amdgcn_global_load_lds((const unsigned*)(pq + (t0_ + row) * 3072 + 2048 + h * 128 + half * 64 + (l_ & 7) * 8), (LAS unsigned*)(lds + (bf) * SC_BUF2 + 45056 + i4 * 1024), 16, 0, 0); } } } while (0)
    if (!compute) { GDN_ISSUE(0, 0); GDN_ISSUE(1, 1); asm volatile("s_waitcnt vmcnt(13)" ::: "memory"); }
    __syncthreads();
    for (int n = 0; n < 128; ++n) {
        const int bf = n % 3;
        if (!compute) { if (n + 2 < 128) { GDN_ISSUE(n + 2, (n + 2) % 3); } }
        else {
            const LAS unsigned char* L = lds + bf * SC_BUF2;
            const LAS float* sc = (const LAS float*)(L + 53248);
            bf16x8 fa[16], ft[6];
#pragma unroll
            for (int ks = 0; ks < 4; ++ks)
#pragma unroll
                for (int mb = 0; mb < 4; ++mb) { const int rowoff = (16 * mb + r) * 256, ch1 = 4 * ks + (g >> 1), within = 8 * (g & 1);
                    const u32x2 k1 = *(const LAS u32x2*)(L + rowoff + ((ch1 ^ fsw) << 4) + within), k2 = *(const LAS u32x2*)(L + rowoff + (((ch1 + 2) ^ fsw) << 4) + within);
                    fa[mb * 4 + ks] = __builtin_bit_cast(bf16x8, __builtin_shufflevector(k1, k2, 0, 1, 2, 3)); }
#pragma unroll
            for (int i = 0; i < 6; ++i) ft[i] = *(const LAS bf16x8*)(L + 32768 + (i * 64 + lane) * 16);
            bf16x8 SB[4];
#pragma unroll
            for (int ks = 0; ks < 4; ++ks) SB[ks] = pack8(S[2 * ks], S[2 * ks + 1]);
            __builtin_amdgcn_sched_barrier(0);
            f32x4 KS[4];
#pragma unroll
            for (int mb = 0; mb < 4; ++mb) KS[mb] = (f32x4){0.f, 0.f, 0.f, 0.f};
#pragma unroll
            for (int ks = 0; ks < 4; ++ks)
#pragma unroll
                for (int mb = 0; mb < 4; ++mb) KS[mb] = MFMA16(fa[mb * 4 + ks], SB[ks], KS[mb]);
            f32x4 Vn[4];
            { f32x4 R[4];
#pragma unroll
              for (int mb = 0; mb < 4; ++mb) { const f32x4 be = *(const LAS f32x4*)(sc + 16 * mb + 4 * g), eg = *(const LAS f32x4*)(sc + 64 + 16 * mb + 4 * g);
#pragma unroll
                  for (int jj = 0; jj < 4; ++jj) { const float vv = bf2f(*(const LAS bf16_t*)(L + 45056 + (16 * mb + 4 * g + jj) * 128 + (16 * (wave & 3) + r) * 2)); R[mb][jj] = be[jj] * (vv - eg[jj] * KS[mb][jj]); } }
              bf16x8 RB[2]; RB[0] = pack8(R[0], R[1]); RB[1] = pack8(R[2], R[3]);
#pragma unroll
              for (int mb = 0; mb < 4; ++mb) Vn[mb] = (f32x4){0.f, 0.f, 0.f, 0.f};
#pragma unroll
              for (int ks2 = 0; ks2 < 2; ++ks2)
#pragma unroll
                  for (int mb = 0; mb < 4; ++mb) if (!(ks2 == 1 && mb < 2)) Vn[mb] = MFMA16(ft[mb == 0 ? 0 : (mb == 1 ? 1 : 2 * mb - 2 + ks2)], RB[ks2], Vn[mb]); }
            __builtin_amdgcn_sched_barrier(0);
#pragma unroll
            for (int ks2 = 0; ks2 < 2; ++ks2)
#pragma unroll
                for (int mp = 0; mp < 8; ++mp) {
                    const int row1 = 32 * ks2 + 4 * g + q4, chn = ((2 * mp + (p4 >> 1)) ^ ftr) << 4, wi = 8 * (p4 & 1);
                    const s16x4 lo = __builtin_amdgcn_ds_read_tr16_b64_v4i16((LAS s16x4*)(L + row1 * 256 + chn + wi));
                    const s16x4 hi = __builtin_amdgcn_ds_read_tr16_b64_v4i16((LAS s16x4*)(L + (row1 + 16) * 256 + chn + wi));
                    fa[mp * 2 + ks2] = __builtin_shufflevector(lo, hi, 0, 1, 2, 3, 4, 5, 6, 7); }
            bf16x8 VB[2], VdB[2];
            { VB[0] = pack8(Vn[0], Vn[1]); VB[1] = pack8(Vn[2], Vn[3]);
#pragma unroll
              for (int mb = 0; mb < 4; ++mb) Vn[mb] = *(const LAS f32x4*)(sc + 128 + 16 * mb + 4 * g) * Vn[mb];
              VdB[0] = pack8(Vn[0], Vn[1]); VdB[1] = pack8(Vn[2], Vn[3]); }
            { const float egl = sc[192];
#pragma unroll
              for (int mp = 0; mp < 8; ++mp) S[mp] = S[mp] * egl; }
            __builtin_amdgcn_sched_barrier(0);
#pragma unroll
            for (int ks2 = 0; ks2 < 2; ++ks2)
#pragma unroll
                for (int mp = 0; mp < 8; ++mp) S[mp] = MFMA16(fa[mp * 2 + ks2], VdB[ks2], S[mp]);
            __builtin_amdgcn_sched_barrier(0);
#pragma unroll
            for (int ks = 0; ks < 4; ++ks)
#pragma unroll
                for (int mb = 0; mb < 4; ++mb) { const int rowoff = 16384 + (16 * mb + r) * 256, ch1 = 4 * ks + (g >> 1), within = 8 * (g & 1);
                    const u32x2 q1 = *(const LAS u32x2*)(L + rowoff + ((ch1 ^ fsw) << 4) + within), q2 = *(const LAS u32x2*)(L + rowoff + (((ch1 + 2) ^ fsw) << 4) + within);
                    fa[mb * 4 + ks] = __builtin_bit_cast(bf16x8, __builtin_shufflevector(q1, q2, 0, 1, 2, 3)); }
#pragma unroll
            for (int i = 0; i < 6; ++i) ft[i] = *(const LAS bf16x8*)(L + 38912 + (i * 64 + lane) * 16);
            __builtin_amdgcn_sched_barrier(0);
            f32x4 O[4];
#pragma unroll
            for (int mb = 0; mb < 4; ++mb) O[mb] = (f32x4){0.f, 0.f, 0.f, 0.f};
#pragma unroll
            for (int ks = 0; ks < 4; ++ks)
#pragma unroll
                for (int mb = 0; mb < 4; ++mb) O[mb] = MFMA16(fa[mb * 4 + ks], SB[ks], O[mb]);
#pragma unroll
            for (int mb = 0; mb < 4; ++mb) O[mb] = *(const LAS f32x4*)(sc + 64 + 16 * mb + 4 * g) * O[mb];
#pragma unroll
            for (int ks2 = 0; ks2 < 2; ++ks2)
#pragma unroll
                for (int mb = 0; mb < 4; ++mb) if (!(ks2 == 1 && mb < 2)) O[mb] = MFMA16(ft[mb == 0 ? 0 : (mb == 1 ? 1 : 2 * mb - 2 + ks2)], VB[ks2], O[mb]);
            __builtin_amdgcn_sched_barrier(0);
            const size_t t0 = (size_t)b * SEQ + 64 * n;
#pragma unroll
            for (int mb = 0; mb < 4; ++mb)
#pragma unroll
                for (int jj = 0; jj < 4; ++jj) mix[(t0 + 16 * mb + 4 * g + jj) * 1536 + h * 128 + 16 * s + r] = (bf16_t)(pk2(O[mb][jj], 0.f) & 0xffffu);
        }
        if (!compute) { if (n + 2 < 128) asm volatile("s_waitcnt vmcnt(13)" ::: "memory"); else asm volatile("s_waitcnt vmcnt(0)" ::: "memory"); }
        __syncthreads();
    }
#undef GDN_ISSUE
}

constexpr size_t S5_AALL = 0, S5_ZG = 80 * MiB, S5_BTALL = 144 * MiB, S5_BTE = 184 * MiB, S5_E = 204 * MiB;
__device__ __forceinline__ void sincos_d(double x, double& s, double& c) {
    const double k = __builtin_rint(x * 0.15915494309189535); const double r = x - k * 6.283185307179586476925; const double r2 = r * r;
    double ts = 1.0, ss = 1.0, tc = 1.0, cs = 1.0;
#pragma unroll
    for (int n = 1; n <= 13; ++n) { ts *= -r2 / (double)((2 * n) * (2 * n + 1)); ss += ts; tc *= -r2 / (double)((2 * n - 1) * (2 * n)); cs += tc; }
    s = r * ss; c = cs;
}
__device__ __forceinline__ float gelu_tanh(float x) { const float u = 0.7978845608028654f * (x + 0.044715f * x * x * x); const float t = 1.f - 2.f / (__expf(2.f * u) + 1.f); return 0.5f * x * (1.f + t); }
__device__ __forceinline__ void s5_apow(const Params& p, int j, int g, int pp, int tau, float& ar, float& ai) {
    const size_t gp = ((size_t)j * 64 + g) * 64 + pp; const float are = p.in[16][gp], aim = p.in[17][gp], dt = __expf(p.in[22][j * 64 + g]);
    const float m = expf(are * dt * (float)tau); double sd, cd; sincos_d((double)aim * (double)dt * (double)tau, sd, cd); ar = m * (float)cd; ai = m * (float)sd;
}
__device__ __forceinline__ void ph_s5_build(int wv, const Params& p, int j, unsigned char* smem, int blk0, int nblk, bool tables) {
    float* Apr = (float*)smem; float* Api = Apr + 33 * 64; float* Bbr = Api + 33 * 64; float* Bbi = Bbr + 1024; float* Ccr = Bbi + 1024; float* Cci = Ccr + 1024; float* Kt = Cci + 1024;
    bf16_t* AALL = (bf16_t*)(p.ws + WS_R1 + S5_AALL); bf16_t* BTALL = (bf16_t*)((unsigned char*)p.out + 64 * MiB); bf16_t* BTE = (bf16_t*)((unsigned char*)p.out + 104 * MiB);
    const int tid = otid(wv);
    if (!tables) { for (int c = blockIdx.x * 512 + tid; c < 65536 * 16; c += gridDim.x * 512) { const int rr = c >> 4, ch = c & 15; unsigned zz = 0u; asm volatile("" : "+v"(zz)); u32x4 z = {zz, zz, zz, zz}; *(u32x4*)(AALL + ((size_t)rr * 640 + 512 + ch * 8)) = z; } return; }
    if ((int)blockIdx.x < blk0) return;
    for (int job = (int)blockIdx.x - blk0; job < 256; job += nblk) {
        const int g = job >> 2, q = job & 3;
        __syncthreads();
        for (int e = tid; e < 33 * 64; e += 512) { float ar, ai; s5_apow(p, j, g, e & 63, e >> 6, ar, ai); Apr[e] = ar; Api[e] = ai; }
        for (int e = tid; e < 1024; e += 512) { const int i = e >> 6, pp = e & 63; const size_t o = (((size_t)j * 64 + g) * 16 + i) * 64 + pp; Ccr[e] = p.in[20][o]; Cci[e] = p.in[21][o]; }
        __syncthreads();
        for (int e = tid; e < 1024; e += 512) { const int pp = e >> 4, i = e & 15; const size_t gp = ((size_t)j * 64 + g) * 64 + pp; const float are = p.in[16][gp], aim = p.in[17][gp];
            const float abr = Apr[64 + pp], abi = Api[64 + pp], den = are * are + aim * aim, nre = abr - 1.f, nim = abi;
            const float fre = (nre * are + nim * aim) / den, fim = (nim * are - nre * aim) / den; const float br = p.in[18][gp * 16 + i], bi = p.in[19][gp * 16 + i];
            Bbr[e] = fre * br - fim * bi; Bbi[e] = fre * bi + fim * br; }
        __syncthreads();
        { const int tau = tid >> 4, i = tid & 15; float acc[16];
#pragma unroll
          for (int ip = 0; ip < 16; ++ip) acc[ip] = 0.f;
          for (int pp = 0; pp < 64; ++pp) { const float cr = Ccr[i * 64 + pp], ci = Cci[i * 64 + pp], ar = Apr[tau * 64 + pp], ai = Api[tau * 64 + pp]; const float car = cr * ar - ci * ai, cai = cr * ai + ci * ar;
#pragma unroll
              for (int q4 = 0; q4 < 4; ++q4) { const f32x4 br = *(const f32x4*)(Bbr + pp * 16 + q4 * 4), bi = *(const f32x4*)(Bbi + pp * 16 + q4 * 4);
#pragma unroll
                  for (int k = 0; k < 4; ++k) acc[q4 * 4 + k] += car * br[k] - cai * bi[k]; } }
#pragma unroll
          for (int ip = 0; ip < 16; ++ip) Kt[tau * 256 + i * 16 + ip] = acc[ip]; }
        __syncthreads();
        for (int c = tid; c < 128 * 80; c += 512) { const int rloc = c / 80, ch = c - rloc * 80, t = 8 * q + (rloc >> 4), i = rloc & 15, col0 = ch * 8; float v[8];
            if (col0 < 512) { const int s = col0 >> 4, i0 = col0 & 15;
#pragma unroll
                for (int e = 0; e < 8; ++e) v[e] = s <= t ? Kt[(t - s) * 256 + i * 16 + i0 + e] : 0.f; }
            else {
#pragma unroll
                for (int e = 0; e < 8; ++e) { const int pc = col0 - 512 + e, pp = pc & 63; const float cr = Ccr[i * 64 + pp], ci = Cci[i * 64 + pp], ar = Apr[(t + 1) * 64 + pp], ai = Api[(t + 1) * 64 + pp];
                    v[e] = pc < 64 ? cr * ar - ci * ai : -(cr * ai + ci * ar); } }
            u32x4 w; w.x = pk2(v[0], v[1]); w.y = pk2(v[2], v[3]); w.z = pk2(v[4], v[5]); w.w = pk2(v[6], v[7]);
            *(u32x4*)(BTALL + ((size_t)(g * 512 + t * 16 + i) * 640 + col0)) = w; }
        for (int c = tid; c < 64 * 80; c += 512) { const int rr = c / 80, ch = c - rr * 80, col0 = ch * 8; float v[8];
#pragma unroll
            for (int e = 0; e < 8; ++e) v[e] = 0.f;
            if (q < 2 && col0 < 512) { const int s = col0 >> 4, i0 = col0 & 15; const float ar = Apr[(31 - s) * 64 + rr], ai = Api[(31 - s) * 64 + rr];
#pragma unroll
                for (int e = 0; e < 8; ++e) { const float br = Bbr[rr * 16 + i0 + e], bi = Bbi[rr * 16 + i0 + e]; v[e] = q == 0 ? ar * br - ai * bi : ar * bi + ai * br; } }
            u32x4 w; w.x = pk2(v[0], v[1]); w.y = pk2(v[2], v[3]); w.z = pk2(v[4], v[5]); w.w = pk2(v[6], v[7]);
            *(u32x4*)(BTE + ((size_t)(g * 256 + 64 * q + rr) * 640 + col0)) = w; }
    }
}
__device__ __forceinline__ void ph_s5_carry(int wv, const Params& p, int j, float* ldsf) {
    const int tid = otid(wv), pp = tid & 63, seg = tid >> 6;
    for (int gb = blockIdx.x; gb < 256; gb += gridDim.x) {
        const int g = gb >> 2, b = gb & 3;
        float ar, ai; s5_apow(p, j, g, pp, 32, ar, ai);
        const float* E = (const float*)(p.ws + WS_R1 + S5_E) + (size_t)(g * 1024 + b * 256 + seg * 32) * 128; bf16_t* A = (bf16_t*)(p.ws + WS_R1 + S5_AALL) + (size_t)(g * 1024 + b * 256 + seg * 32) * 640 + 512;
        float er[32], ei[32];
#pragma unroll
        for (int k = 0; k < 32; ++k) { er[k] = E[(size_t)k * 128 + pp]; ei[k] = E[(size_t)k * 128 + 64 + pp]; }
        float hr = 0.f, hi = 0.f, pr = 1.f, pi = 0.f;
#pragma unroll
        for (int k = 0; k < 32; ++k) { const float nr = ar * hr - ai * hi + er[k], ni = ar * hi + ai * hr + ei[k]; hr = nr; hi = ni; const float qr = pr * ar - pi * ai, qi = pr * ai + pi * ar; pr = qr; pi = qi; }
        __syncthreads();
        ldsf[tid] = hr; ldsf[512 + tid] = hi;
        __syncthreads();
        float sr = 0.f, si = 0.f;
        for (int s2 = 0; s2 < seg; ++s2) { const float lr = ldsf[s2 * 64 + pp], li = ldsf[512 + s2 * 64 + pp]; const float nr = pr * sr - pi * si + lr, ni = pr * si + pi * sr + li; sr = nr; si = ni; }
        hr = sr; hi = si;
#pragma unroll
        for (int k = 0; k < 32; ++k) { A[(size_t)k * 640 + pp] = (bf16_t)(pk2(hr, 0.f) & 0xffffu); A[(size_t)k * 640 + 64 + pp] = (bf16_t)(pk2(hi, 0.f) & 0xffffu);
            const float nr = ar * hr - ai * hi + er[k], ni = ar * hi + ai * hr + ei[k]; hr = nr; hi = ni; }
    }
}
struct S5SchedE { int G, c, wv; __device__ __forceinline__ bool next(int i, Unit& u) const { const int L = i * G + c; if (L >= 256) return false; u.pm = L; u.pn = L >> 2; u.aux = 0; return true; }
    __device__ __forceinline__ void a_ready(const Unit&) const {} __device__ __forceinline__ void done(const Unit&) const {} };
struct S5SchedM { int G, c, wv; __device__ __forceinline__ bool next(int i, Unit& u) const { const int L = i * G + c; if (L >= 512) return false; const int g = L >> 3; u.pm = g * 4 + ((L >> 1) & 3); u.pn = g * 2 + (L & 1); u.aux = 0; return true; }
    __device__ __forceinline__ void a_ready(const Unit&) const {} __device__ __forceinline__ void done(const Unit&) const {} };
struct EpiS5E {
    static constexpr bool PERM = false, AFTER_DRAIN = false; float* E;
    __device__ __forceinline__ void operator()(const f32x4 (&acc)[2][2][4][2], const Unit& u, int wr, int wc, int fr, int fq) const {
        const int row0 = u.pm * 256 + wr * 64 + fr, col0 = wc * 32 + 4 * fq;
#pragma unroll
        for (int ai = 0; ai < 2; ++ai)
#pragma unroll
            for (int m = 0; m < 4; ++m)
#pragma unroll
                for (int n = 0; n < 2; ++n) *(f32x4*)(E + (size_t)(row0 + ai * 128 + m * 16) * 128 + col0 + n * 16) = acc[ai][0][m][n];
    }
};
struct EpiS5M {
    static constexpr bool PERM = true, AFTER_DRAIN = false; const bf16_t* AALL; bf16_t* ZG; const float* dsk;
    __device__ __forceinline__ void operator()(const f32x4 (&acc)[2][2][4][2], const Unit& u, int wr, int wc, int fr, int fq) const {
        const int row0 = u.pm * 256 + wr * 64 + fr, colb = u.pn * 256 + wc * 32 + 8 * fq;
#pragma unroll
        for (int ai = 0; ai < 2; ++ai)
#pragma unroll
            for (int m = 0; m < 4; ++m) { const int row = row0 + ai * 128 + m * 16, g = row >> 10, rowl = row & 1023;
#pragma unroll
                for (int bj = 0; bj < 2; ++bj) { const int cl = colb + bj * 128 - g * 512, t = cl >> 4, i0 = cl & 15; const size_t tok = (size_t)rowl * 32 + t;
                    const u32x4 uu = *(const u32x4*)(AALL + (size_t)row * 640 + t * 16 + i0); const f32x4 d0 = *(const f32x4*)(dsk + g * 16 + i0), d1 = *(const f32x4*)(dsk + g * 16 + i0 + 4);
                    const f32x4 v0 = acc[ai][bj][m][0], v1 = acc[ai][bj][m][1]; u32x4 w;
                    w.x = pk2(gelu_tanh(v0[0] + d0[0] * bflo(uu.x)), gelu_tanh(v0[1] + d0[1] * bfhi(uu.x))); w.y = pk2(gelu_tanh(v0[2] + d0[2] * bflo(uu.y)), gelu_tanh(v0[3] + d0[3] * bfhi(uu.y)));
                    w.z = pk2(gelu_tanh(v1[0] + d1[0] * bflo(uu.z)), gelu_tanh(v1[1] + d1[1] * bfhi(uu.z))); w.w = pk2(gelu_tanh(v1[2] + d1[2] * bflo(uu.w)), gelu_tanh(v1[3] + d1[3] * bfhi(uu.w)));
                    *(u32x4*)(ZG + tok * 1024 + g * 16 + i0) = w; } }
    }
};
template <class Epi, class Sched> __device__ __forceinline__ void run_gemm_s(int wv, LAS unsigned char* lds, const bf16_t* A, const bf16_t* Bt, int M, int N, int K, const Epi& E) {
    pg8::Gemm g; g.A = A; g.Bt = Bt; g.M = M; g.N = N; g.K = K;
    Sched S; S.G = (int)gridDim.x; S.c = (int)blockIdx.x; S.wv = wv;
    pg8::gemm_phase<Epi, Sched, false>(lds, g, S, E, nullptr);
}

constexpr size_t WS_KMEM = 35 * MiB, WS_VT = 36 * MiB;
struct OffSched { int base, cnt, nN, wv; __device__ __forceinline__ bool next(int i, Unit& u) const { const int L = (int)blockIdx.x - base; if (i > 0 || L < 0 || L >= cnt) return false; u.pm = L / nN; u.pn = L % nN; u.aux = 0; return true; }
    __device__ __forceinline__ void a_ready(const Unit&) const {} __device__ __forceinline__ void done(const Unit&) const {} };
struct EpiPlain { static constexpr bool PERM = true, AFTER_DRAIN = false; bf16_t* O; int ld;
    __device__ __forceinline__ void operator()(const f32x4 (&acc)[2][2][4][2], const Unit& u, int wr, int wc, int fr, int fq) const {
        const int row0 = u.pm * 256 + wr * 64 + fr, colb = u.pn * 256 + wc * 32 + 8 * fq;
#pragma unroll
        for (int ai = 0; ai < 2; ++ai)
#pragma unroll
            for (int m = 0; m < 4; ++m)
#pragma unroll
                for (int bj = 0; bj < 2; ++bj) { const f32x4 v0 = acc[ai][bj][m][0], v1 = acc[ai][bj][m][1]; u32x4 w; w.x = pk2(v0[0], v0[1]); w.y = pk2(v0[2], v0[3]); w.z = pk2(v1[0], v1[1]); w.w = pk2(v1[2], v1[3]);
                    *(u32x4*)(O + (size_t)(row0 + ai * 128 + m * 16) * ld + colb + bj * 128) = w; }
    }
};
__device__ __forceinline__ void ph_xattn(int wv, const Params& p, unsigned char* smem, int blk0 = 0, int nblk = 0, const bool dry = false) {
    const int tid = otid(wv), wave = __builtin_amdgcn_readfirstlane(tid >> 6), lane = tid & 63, r = lane & 15, g = lane >> 4;
    const bf16_t* Kg = (const bf16_t*)(p.ws + WS_KMEM); const bf16_t* Vg = (const bf16_t*)(p.ws + WS_VT); bf16_t* mix = (bf16_t*)(p.ws + WS_MIX);
    LAS unsigned char* lds = (LAS unsigned char*)smem;
    if (nblk == 0) nblk = (int)gridDim.x;
    if ((int)blockIdx.x < blk0) return;
    for (int vb = (int)blockIdx.x - blk0; vb < 256; vb += nblk) {
        const int b = vb >> 6, h = (vb >> 4) & 3, tb = vb & 15;
        __syncthreads();
#pragma unroll
        for (int ii = 0; ii < 8; ++ii) { const int i = wave * 8 + ii; const int row = 4 * i + g, ch = r ^ (row & 15);
            __builtin_amdgcn_global_load_lds((const unsigned*)(Kg + (size_t)(b * 256 + row) * 512 + h * 128 + ch * 8), (LAS unsigned*)(lds + i * 1024), 16, 0, 0); }
#pragma unroll
        for (int ii = 0; ii < 8; ++ii) { const int i = wave * 8 + ii; const int row = 2 * i + (lane >> 5), ch = (lane & 31) ^ (row & 15);
            __builtin_amdgcn_global_load_lds((const unsigned*)(Vg + (size_t)(h * 128 + row) * 1024 + b * 256 + ch * 8), (LAS unsigned*)(lds + 65536 + i * 1024), 16, 0, 0); }
        asm volatile("s_waitcnt vmcnt(0)" ::: "memory");
        __syncthreads();
#pragma unroll 1
        for (int it = 0; it < 4; ++it) {
            const size_t tok0 = (size_t)b * SEQ + tb * 512 + (wave * 4 + it) * 16;
            bf16_t* qp = mix + (tok0 + r) * 1536 + 1024 + h * 128;
            bf16x8 qf[4];
#pragma unroll
            for (int ks = 0; ks < 4; ++ks) qf[ks] = *(const bf16x8*)(qp + 32 * ks + 8 * g);
            f32x4 St[16];
#pragma unroll
            for (int kb = 0; kb < 16; ++kb) { St[kb] = (f32x4){0.f, 0.f, 0.f, 0.f};
#pragma unroll
                for (int ks = 0; ks < 4; ++ks) St[kb] = MFMA16(*(const LAS bf16x8*)(lds + (16 * kb + r) * 256 + (((4 * ks + g) ^ r) << 4)), qf[ks], St[kb]);
                __builtin_amdgcn_sched_barrier(0); }
            float mx = -3.0e38f;
#pragma unroll
            for (int kb = 0; kb < 16; ++kb)
#pragma unroll
                for (int jj = 0; jj < 4; ++jj) mx = fmaxf(mx, St[kb][jj]);
            mx = fmaxf(mx, __shfl_xor(mx, 16)); mx = fmaxf(mx, __shfl_xor(mx, 32));
            float sum = 0.f;
#pragma unroll
            for (int kb = 0; kb < 16; ++kb)
#pragma unroll
                for (int jj = 0; jj < 4; ++jj) { const float e = __expf((St[kb][jj] - mx) * 0.08838834764831845f); St[kb][jj] = e; sum += e; }
            sum += __shfl_xor(sum, 16); sum += __shfl_xor(sum, 32);
            const float inv = 1.f / sum;
            bf16x8 PB[8];
#pragma unroll
            for (int k2 = 0; k2 < 8; ++k2) PB[k2] = pack8(St[2 * k2], St[2 * k2 + 1]);
#pragma unroll
            for (int db = 0; db < 8; ++db) { f32x4 O = {0.f, 0.f, 0.f, 0.f};
#pragma unroll
                for (int k2 = 0; k2 < 8; ++k2) { const int rowoff = 65536 + (16 * db + r) * 512, ch1 = 4 * k2 + (g >> 1), o8 = 8 * (g & 1);
                    const u32x2 v1 = *(const LAS u32x2*)(lds + rowoff + ((ch1 ^ r) << 4) + o8), v2 = *(const LAS u32x2*)(lds + rowoff + (((ch1 + 2) ^ r) << 4) + o8);
                    u32x4 vw; vw.x = v1.x; vw.y = v1.y; vw.z = v2.x; vw.w = v2.y;
                    O = MFMA16(__builtin_bit_cast(bf16x8, vw), PB[k2], O); }
                u32x2 ow; ow.x = pk2(O[0] * inv, O[1] * inv); ow.y = pk2(O[2] * inv, O[3] * inv);
                if (!dry) *(u32x2*)(qp + 16 * db + 4 * g) = ow; else if (ow.x == 0x12345u) qp[0] = 1;
                __builtin_amdgcn_sched_barrier(0); }
        }
    }
}

#define XB_TMO      128
#define XB_XCNT(j)  (256  + 64 * (j))
#define XB_XSUB(j)  (1280 + 64 * (j))
#define XB_XGEN(j)  (2304 + 64 * (j))
#define XB_TOP      3328
#define XB_TOPGEN   3392
#define XCD_BAR_WORDS 3456
#define XB_SPIN_CAP (1u << 18)

__device__ __forceinline__ unsigned xb_ld(unsigned* p)              { return __hip_atomic_load(p, __ATOMIC_RELAXED, __HIP_MEMORY_SCOPE_AGENT); }
__device__ __forceinline__ unsigned xb_add(unsigned* p, unsigned v) { return __hip_atomic_fetch_add(p, v, __ATOMIC_RELAXED, __HIP_MEMORY_SCOPE_AGENT); }
__device__ __forceinline__ unsigned xb_xcc_id() { return (unsigned)__builtin_amdgcn_s_getreg((3 << 11) | 20) & 0xFu; }
#define XB_SPIN(cond, bar) do { unsigned _sp = 0; while (cond) { __builtin_amdgcn_s_sleep(1); \
    if ((++_sp & 255u) == 0u) { if (xb_ld(&(bar)[XB_TMO])) break; if (_sp > XB_SPIN_CAP) { atomicAdd(&(bar)[XB_TMO], 1u); break; } } } } while (0)

struct XcdBarrier {
    unsigned* bar; unsigned x; int wv;
    volatile LAS unsigned* st;
};

__device__ __forceinline__ XcdBarrier xcd_barrier_post(unsigned* bar, volatile LAS unsigned* st) {
    XcdBarrier b; b.bar = bar; b.x = xb_xcc_id(); b.st = st;
    if (threadIdx.x == 0) (void)xb_add(&bar[XB_XCNT(b.x)], 1u);
    return b;
}
__device__ __forceinline__ void xcd_barrier_complete(unsigned* bar, unsigned x, unsigned& nloc, unsigned& nx) {
    const unsigned G = gridDim.x * gridDim.y * gridDim.z;
    unsigned sum, cnt, mine, sp = 0u;
    for (;;) {
        sum = 0u; cnt = 0u; mine = 0u;
#pragma unroll
        for (unsigned j = 0; j < 16; ++j) { const unsigned c = xb_ld(&bar[XB_XCNT(j)]); sum += c; cnt += (c > 0u) ? 1u : 0u; mine = (j == x) ? c : mine; }
        if (sum == G) break;
        __builtin_amdgcn_s_sleep(1);
        if ((++sp & 255u) == 0u) { if (xb_ld(&bar[XB_TMO])) break; if (sp > XB_SPIN_CAP) { atomicAdd(&bar[XB_TMO], 1u); break; } }
    }
    nloc = mine > 0u ? mine : 1u; nx = cnt > 0u ? cnt : 1u;
}

__device__ __forceinline__ void xcd_barrier(const XcdBarrier& b) {
    asm volatile("s_waitcnt vmcnt(0)" ::: "memory");
    __syncthreads();
    unsigned xm_ = ~0u; asm volatile("" : "+s"(xm_));
    if (b.wv == 0 && __builtin_amdgcn_mbcnt_hi(xm_, __builtin_amdgcn_mbcnt_lo(xm_, 0u)) == 0u) {
        unsigned* bar = b.bar;
        __builtin_amdgcn_s_waitcnt(0);
        unsigned nloc = b.st[0], nx = b.st[1];
        if (nloc == 0u) { xcd_barrier_complete(bar, b.x, nloc, nx); b.st[0] = nloc; b.st[1] = nx; }
        const unsigned old = xb_add(&bar[XB_XSUB(b.x)], 1u);
        const unsigned gen = old / nloc;
        if (old + 1u == (gen + 1u) * nloc) {
            __builtin_amdgcn_fence(__ATOMIC_RELEASE, "agent");
            asm volatile("s_waitcnt vmcnt(0)" ::: "memory");
            const unsigned og = xb_add(&bar[XB_TOP], 1u);
            const unsigned tg = og / nx;
            if (og + 1u == (tg + 1u) * nx) xb_add(&bar[XB_TOPGEN], 1u);
            else XB_SPIN(xb_ld(&bar[XB_TOPGEN]) == tg, bar);
            __builtin_amdgcn_fence(__ATOMIC_ACQUIRE, "agent");
            xb_add(&bar[XB_XGEN(b.x)], 1u);
            asm volatile("s_waitcnt vmcnt(0)" ::: "memory");
        } else {
            XB_SPIN(xb_ld(&bar[XB_XGEN(b.x)]) == gen, bar);
            __builtin_amdgcn_fence(__ATOMIC_ACQUIRE, "agent");
            asm volatile("s_waitcnt vmcnt(0)" ::: "memory");
        }
    }
    __syncthreads();
}


__global__ void __launch_bounds__(512) fwd_mega(Params p) {
    extern __shared__ __attribute__((aligned(16))) unsigned char shm[];
    LAS unsigned char* lds = (LAS unsigned char*)shm; float* ldsf = (float*)shm;
    cg::grid_group grid = cg::this_grid();
    const int wv = __builtin_amdgcn_readfirstlane((int)threadIdx.x >> 6);
    unsigned char* ws = p.ws;
    bf16_t* XB = (bf16_t*)(ws + WS_XB); bf16_t* MIX = (bf16_t*)(ws + WS_MIX); bf16_t* R1 = (bf16_t*)(ws + WS_R1);
    volatile LAS unsigned* bst = (volatile LAS unsigned*)(lds + LDS_BYTES - 16);
    if (threadIdx.x == 0) { bst[0] = 0u; bst[1] = 0u; }
    __syncthreads();
    XcdBarrier xb = xcd_barrier_post((unsigned*)(ws + WS_BAR), bst); xb.wv = wv;
    for (int ph = p.ph_lo; ph < p.ph_hi; ++ph) {
#ifdef REP_SUB
        const int layer = ph / (NPH + 1), sub0 = ph % (NPH + 1), sub = sub0 <= REP_SUB ? sub0 : sub0 - 1, j = layer >> 1; const bool gdn = (layer & 1) == 0;
        if (sub0 == REP_SUB + 1 && REP_SUB == 4 && gdn) continue;
#else
        const int layer = ph / NPH, sub = ph % NPH, j = layer >> 1; const bool gdn = (layer & 1) == 0;
#endif
        if ((sub == 5 && gdn) || (sub == 0 && layer > 0) || sub == 7 || (sub == 10 && layer < 3) || (sub == 3 && !gdn && gridDim.x == 256)) continue;
        float* CS = (float*)(ws + WS_CSUM); float* STPA = (float*)(ws + WS_STPA); float* STPB = (float*)(ws + WS_STPB);
        if (sub == 0) { cvt_rows(wv, p.in[0], XB, (size_t)T_TOK * DM); cvt_rows(wv, p.in[1], (bf16_t*)(ws + WS_MEMB), (size_t)1024 * 1024);
            ph_convert_in(wv, p, 0, ldsf); }
        else if (sub == 1) {
            if (layer > 0) csum_finalize(wv, CS + ((layer & 1) ? 89600 : 38912), CS + ((layer & 1) ? 105984 : 55296), CS + 81408, CS + 85504, 4096);
            if (gdn) { EpiRoute<0> E; E.o0 = R1; E.o1 = (bf16_t*)(ws + WS_HALO); E.o2 = MIX; E.ba = (float*)(ws + WS_BA); E.zg = (const bf16_t*)(ws + WS_R1 + 192 * MiB); E.bias = nullptr;
                E.stp = layer > 0 ? STPB : nullptr; E.c1 = CS + 71680; E.c2 = CS + 76544; E.sl = lds;
                run_gemm_st(wv, lds, XB, (const bf16_t*)(ws + WS_W_IN), T_TOK, 4864, 1024, E, E.stp); }
            else { EpiRoute<1> E; E.o0 = (bf16_t*)(ws + WS_R1 + S5_AALL); E.o1 = nullptr; E.o2 = MIX; E.ba = nullptr; E.zg = nullptr; E.bias = nullptr; E.stp = STPB; E.c1 = CS + 71680; E.c2 = CS + 76544; E.sl = lds;
                run_gemm_st(wv, lds, XB, (const bf16_t*)(ws + WS_W_IN), T_TOK, 1536, 1024, E, E.stp); }
            { EpiPlain E; E.O = (bf16_t*)(ws + WS_KMEM); E.ld = 512; pg8::Gemm gg; gg.A = (const bf16_t*)(ws + WS_MEMB); gg.Bt = (const bf16_t*)(ws + WS_W_KV); gg.M = 1024; gg.N = 512; gg.K = 1024;
                OffSched S; S.base = (gdn && gridDim.x == 256) ? 128 : 0; S.cnt = 8; S.nN = 2; S.wv = wv; pg8::gemm_phase<EpiPlain, OffSched, false>(lds, gg, S, E, nullptr); }
            { EpiPlain E; E.O = (bf16_t*)(ws + WS_VT); E.ld = 1024; pg8::Gemm gg; gg.A = (const bf16_t*)(ws + WS_W_KV) + (size_t)512 * 1024; gg.Bt = (const bf16_t*)(ws + WS_MEMB); gg.M = 512; gg.N = 1024; gg.K = 1024;
                OffSched S; S.base = (gdn && gridDim.x == 256) ? 136 : 8; S.cnt = 8; S.nN = 4; S.wv = wv; pg8::gemm_phase<EpiPlain, OffSched, false>(lds, gg, S, E, nullptr); }
            if (!gdn) ph_s5_build(wv, p, j, shm, 0, 0, false);
        } else if (sub == 2) {
            if (gdn) ph_gdn_prep(wv, p, j, shm);
            else { EpiS5E E; E.E = (float*)(ws + WS_R1 + S5_E); run_gemm_s<EpiS5E, S5SchedE>(wv, lds, (const bf16_t*)(ws + WS_R1 + S5_AALL), (const bf16_t*)((unsigned char*)p.out + 104 * MiB), 65536, 16384, 640, E);
                if (gridDim.x == 256) { asm volatile("s_waitcnt vmcnt(0)" ::: "memory"); __syncthreads(); ph_s5_carry(wv, p, j, ldsf); } }
            if (!gdn) { __syncthreads(); ph_xattn(wv, p, shm);
                if (layer < 3) { __syncthreads(); ph_convert_in(wv, p, layer + 1, ldsf); ph_convert_wo(wv, p, layer + 1, ldsf); ph_convert_w1(wv, p, layer + 1, ldsf); ph_convert_w2(wv, p, layer + 1, ldsf); } }
        } else if (sub == 3) { if (gdn) { ph_gdn_scan(wv, p, shm); __syncthreads(); ph_xattn(wv, p, shm, 64, (int)gridDim.x - 64); }
            else if (gridDim.x != 256) ph_s5_carry(wv, p, j, ldsf);
            if (layer < 3 && gdn) { const int cb0 = (gdn && gridDim.x > 64) ? 64 : 0, cnb = (int)gridDim.x - cb0;
                __syncthreads();
                if (layer == 0) { ph_convert_wo(wv, p, 0, ldsf, cb0, cnb); ph_convert_w1(wv, p, 0, ldsf, cb0, cnb); ph_convert_w2(wv, p, 0, ldsf, cb0, cnb); }
                ph_convert_in(wv, p, layer + 1, ldsf, cb0, cnb); ph_convert_wo(wv, p, layer + 1, ldsf, cb0, cnb); ph_convert_w1(wv, p, layer + 1, ldsf, cb0, cnb); ph_convert_w2(wv, p, layer + 1, ldsf, cb0, cnb);
                if (gdn) { __syncthreads(); ph_s5_build(wv, p, (layer + 1) >> 1, shm, cb0, cnb, true); } } }
        else if (sub == 4) {
            if (layer == 0) csum_finalize(wv, CS + 38912, CS + 55296, CS + 81408, CS + 85504, 4096);
            if (layer < 3) csum_finalize(wv, CS, CS + 19456, CS + 71680, CS + 76544, (layer & 1) ? 4864 : 1536);
            if (gdn) ph_gdn_gnorm(wv, p, j);
            else { EpiS5M E; E.AALL = (const bf16_t*)(ws + WS_R1 + S5_AALL); E.ZG = (bf16_t*)(ws + WS_R1 + S5_ZG); E.dsk = p.in[23] + (size_t)j * 1024;
                run_gemm_s<EpiS5M, S5SchedM>(wv, lds, (const bf16_t*)(ws + WS_R1 + S5_AALL), (const bf16_t*)((unsigned char*)p.out + 64 * MiB), 65536, 32768, 640, E); }
        } else if (sub == 5) {
            { EpiRoute<4> E; E.o0 = nullptr; E.o1 = nullptr; E.o2 = MIX; E.ba = nullptr; E.zg = (const bf16_t*)(ws + WS_R1 + S5_ZG); E.bias = p.in[25] + (size_t)j * 1024;
                run_gemm(wv, lds, (const bf16_t*)(ws + WS_R1 + S5_ZG), (const bf16_t*)(ws + WS_GLU), T_TOK, 1024, 1024, E); }
        } else if (sub == 6) { EpiRes E; E.res = layer == 0 ? p.in[0] : nullptr; E.g = p.in[6] + (layer > 0 ? layer - 1 : 0) * 1024; E.b = p.in[7] + (layer > 0 ? layer - 1 : 0) * 1024; E.yb = XB; E.stp_out = STPA; E.sl = lds;
            run_gemm_st(wv, lds, MIX, (const bf16_t*)(ws + wofs(layer, WS_W_O, 0)), T_TOK, 1024, 1536, E, layer == 0 ? nullptr : STPB); }
        else if (sub == 8) { EpiRoute<2> E; E.o0 = R1; E.o1 = nullptr; E.o2 = nullptr; E.ba = nullptr; E.zg = nullptr; E.bias = nullptr; E.stp = STPA; E.c1 = CS + 81408; E.c2 = CS + 85504; E.sl = lds;
            run_gemm_st(wv, lds, XB, (const bf16_t*)(ws + wofs(layer, WS_W1, 3 * MiB)), T_TOK, 4096, 1024, E, STPA); }
        else if (sub == 9) { EpiRes E; E.res = nullptr; E.g = p.in[4] + layer * 1024; E.b = p.in[5] + layer * 1024; E.yb = XB; E.stp_out = STPB; E.sl = lds;
            run_gemm_st(wv, lds, R1, (const bf16_t*)(ws + wofs(layer, WS_W2, 11 * MiB)), T_TOK, 1024, 4096, E, STPA); }
        else ph_ln_final(wv, XB, p.out, p.in[6] + layer * 1024, p.in[7] + layer * 1024);
        if (ph + 1 < p.ph_hi) { if (ph == p.ph_lo) grid.sync(); else xcd_barrier(xb); }
    }
}

extern "C" void kernel_launch(void* const* d_in, const int* in_sizes, int n_in, void* d_out, int out_size, void* d_ws, size_t ws_size, hipStream_t stream) {
    static int grid = 0;
    if (grid == 0) {
        int dev = 0, cus = 0, per_cu = 0;
        hipGetDevice(&dev); hipDeviceGetAttribute(&cus, hipDeviceAttributeMultiprocessorCount, dev);
        if (hipFuncSetAttribute((const void*)fwd_mega, hipFuncAttributeMaxDynamicSharedMemorySize, LDS_BYTES) != hipSuccess) fprintf(stderr, "hipFuncSetAttribute failed\n");
        hipOccupancyMaxActiveBlocksPerMultiprocessor(&per_cu, (const void*)fwd_mega, 512, LDS_BYTES);
        if (per_cu < 1) { fprintf(stderr, "occupancy query says %d\n", per_cu); per_cu = 1; }
        (void)hipGetLastError();
        grid = cus;
        if (ws_size < 512 * MiB) fprintf(stderr, "workspace too small: %zu\n", ws_size);
    }
    (void)hipMemsetAsync((unsigned char*)d_ws + WS_BAR, 0, XCD_BAR_WORDS * 4, stream);
    Params p{};
    for (int i = 0; i < 26; ++i) p.in[i] = (const float*)d_in[i];
    p.out = (float*)d_out; p.ws = (unsigned char*)d_ws; p.ph_lo = 0;
#ifdef REP_SUB
    p.ph_hi = 4 * (NPH + 1);
#else
    p.ph_hi = 4 * NPH;
#endif
    void* args[] = {&p};
    hipError_t e = hipLaunchCooperativeKernel((const void*)fwd_mega, dim3(grid), dim3(512), args, LDS_BYTES, stream);
    if (e != hipSuccess) fprintf(stderr, "cooperative launch failed: %s (grid %d)\n", hipGetErrorString(e), grid);
}
```
